# Optimizing an MI355X kernel written in HIP

```python
import jax, jax.numpy as jnp
from jax import lax
import numpy as np

D_MODEL = 2048
BATCH = 4
SEQ = 2048
DEPTH = 2

CHUNK = 64
RET_HEADS = 8
RET_HEAD_DIM = D_MODEL // 16
RET_WIDTH = RET_HEADS * RET_HEAD_DIM
LRU_WIDTH = D_MODEL // 2
LRU_GROUPS = 16
LRU_GROUP_DIM = LRU_WIDTH // LRU_GROUPS
CONV_W = 4
LRU_C = 8.0
MIX_WIDTH = RET_WIDTH + LRU_WIDTH
IN_WIDTH = 4 * RET_WIDTH + 2 * LRU_WIDTH
D_FF = ((8 * D_MODEL // 3 + 255) // 256) * 256
ROPE_BASE = 10000.0
EPS = 1e-6

kernel_name = "hybrid_retention_rglru_swiglu"


def _rmsnorm(x, g):
    xf = x.astype(jnp.float32)
    y = xf * lax.rsqrt(jnp.mean(xf * xf, axis=-1, keepdims=True) + EPS)
    return (y * g.astype(jnp.float32)).astype(x.dtype)


def _rotary(t, pos):
    dk = t.shape[-1]
    inv = 1.0 / (ROPE_BASE ** (jnp.arange(0, dk, 2, dtype=jnp.float32) / dk))
    ang = pos[:, None] * inv[None, :]
    cos = jnp.cos(ang)[None, :, None, :]
    sin = jnp.sin(ang)[None, :, None, :]
    t1, t2 = t[..., : dk // 2], t[..., dk // 2:]
    return jnp.concatenate([t1 * cos - t2 * sin, t1 * sin + t2 * cos], axis=-1)


def _retention(q, k, v, g, gn_g):
    B, T, _ = q.shape
    H, dk, C = RET_HEADS, RET_HEAD_DIM, CHUNK
    nc = T // C
    pos = jnp.arange(T, dtype=jnp.float32)
    q = _rotary(q.reshape(B, T, H, dk), pos)
    k = _rotary(k.reshape(B, T, H, dk), pos) * (dk ** -0.5)
    v = v.reshape(B, T, H, dk)
    qc = q.reshape(B, nc, C, H, dk)
    kc = k.reshape(B, nc, C, H, dk)
    vc = v.reshape(B, nc, C, H, dk)

    log_g = jnp.log1p(-jnp.exp2(-5.0 - jnp.arange(H, dtype=jnp.float32)))
    idx = jnp.arange(C, dtype=jnp.float32)
    dist = jnp.abs(idx[:, None] - idx[None, :])
    d_intra = jnp.exp(log_g[:, None, None] * dist)

    scores = jnp.einsum('bnahd,bnchd->bnhac', qc, kc) * d_intra
    o_intra = jnp.einsum('bnhac,bnche->bnahe', scores, vc)

    k_dec = jnp.exp(log_g[:, None] * (C - 1.0 - idx)[None, :])
    u = jnp.einsum('bnchd,hc,bnche->nbhde', kc, k_dec, vc)
    chunk_dec = jnp.exp(log_g * C)[None, :, None, None]

    def step(s, u_j):
        return chunk_dec * s + u_j, s

    _, s_in = lax.scan(step, jnp.zeros(u.shape[1:], u.dtype), u)
    q_dec = jnp.exp(log_g[:, None] * (idx + 1.0)[None, :])
    o_cross = jnp.einsum('bnahd,ha,nbhde->bnahe', qc, q_dec, s_in)

    o = (o_intra + o_cross).reshape(B, T, H, dk)
    mu = jnp.mean(o, axis=-1, keepdims=True)
    var = jnp.mean(jnp.square(o - mu), axis=-1, keepdims=True)
    on = ((o - mu) * lax.rsqrt(var + EPS)).reshape(B, T, RET_WIDTH) * gn_g
    return on * jax.nn.silu(g)


def _rg_lru_branch(xb, yb, conv_w, conv_b, wa, ba, wx, bx, lam, norm_g):
    B, T, W = xb.shape
    xp = jnp.pad(xb, ((0, 0), (CONV_W - 1, 0), (0, 0)))
    xc = conv_b + sum(xp[:, j:j + T] * conv_w[j] for j in range(CONV_W))
    xg = xc.reshape(B, T, LRU_GROUPS, LRU_GROUP_DIM)
    r = jax.nn.sigmoid(jnp.einsum('btgi,gij->btgj', xg, wa).reshape(B, T, W) + ba)
    i = jax.nn.sigmoid(jnp.einsum('btgi,gij->btgj', xg, wx).reshape(B, T, W) + bx)
    log_a = -LRU_C * r * jax.nn.softplus(-lam)
    a = jnp.exp(log_a)
    b = jnp.sqrt(-jnp.expm1(2.0 * log_a)) * (i * xc)

    def comb(left, right):
        a1, b1 = left
        a2, b2 = right
        return a1 * a2, a2 * b1 + b2

    _, h = lax.associative_scan(comb, (a, b), axis=1)
    y = h * jax.nn.gelu(yb)
    y = y * lax.rsqrt(jnp.mean(y * y, axis=-1, keepdims=True) + EPS)
    return y * norm_g


def setup_inputs(seed: int = 0) -> dict:
    key = jax.random.key(seed)
    ks = jax.random.split(key, 20)
    f32 = jnp.float32

    def nrm(k, shape, scale):
        return jax.random.normal(k, shape, f32) * scale

    def gain(k, shape):
        return 1.0 + 0.02 * jax.random.normal(k, shape, f32)

    u = jax.random.uniform(ks[13], (DEPTH, LRU_WIDTH), f32, 0.9, 0.999)
    a0 = u ** (1.0 / LRU_C)
    lam = jnp.log(a0) - jnp.log1p(-a0)
    return {
        "x": nrm(ks[0], (BATCH, SEQ, D_MODEL), 1.0),
        "norm1_g": gain(ks[1], (DEPTH, D_MODEL)),
        "w_in": nrm(ks[2], (DEPTH, D_MODEL, IN_WIDTH), D_MODEL ** -0.5),
        "ret_gn_g": gain(ks[3], (DEPTH, RET_WIDTH)),
        "lru_conv_w": nrm(ks[4], (DEPTH, CONV_W, LRU_WIDTH), CONV_W ** -0.5),
        "lru_conv_b": nrm(ks[5], (DEPTH, LRU_WIDTH), 0.01),
        "lru_wa": nrm(ks[6], (DEPTH, LRU_GROUPS, LRU_GROUP_DIM, LRU_GROUP_DIM), LRU_GROUP_DIM ** -0.5),
        "lru_ba": nrm(ks[7], (DEPTH, LRU_WIDTH), 0.01),
        "lru_wx": nrm(ks[8], (DEPTH, LRU_GROUPS, LRU_GROUP_DIM, LRU_GROUP_DIM), LRU_GROUP_DIM ** -0.5),
        "lru_bx": nrm(ks[9], (DEPTH, LRU_WIDTH), 0.01),
        "lru_lambda": lam,
        "lru_norm_g": gain(ks[10], (DEPTH, LRU_WIDTH)),
        "w_out": nrm(ks[11], (DEPTH, MIX_WIDTH, D_MODEL), MIX_WIDTH ** -0.5),
        "norm2_g": gain(ks[12], (DEPTH, D_MODEL)),
        "ffn_w_gate": nrm(ks[14], (DEPTH, D_MODEL, D_FF), D_MODEL ** -0.5),
        "ffn_w_up": nrm(ks[15], (DEPTH, D_MODEL, D_FF), D_MODEL ** -0.5),
        "ffn_w_down": nrm(ks[16], (DEPTH, D_FF, D_MODEL), D_FF ** -0.5),
        "final_g": gain(ks[17], (D_MODEL,)),
    }


def reference(x, norm1_g, w_in, ret_gn_g, lru_conv_w, lru_conv_b, lru_wa, lru_ba,
              lru_wx, lru_bx, lru_lambda, lru_norm_g, w_out, norm2_g,
              ffn_w_gate, ffn_w_up, ffn_w_down, final_g):
    f32 = jnp.float32
    R, L = RET_WIDTH, LRU_WIDTH
    for l in range(DEPTH):
        h = _rmsnorm(x, norm1_g[l])
        p = (h @ w_in[l]).astype(f32)
        q, k, v, g, xb, yb = jnp.split(p, [R, 2 * R, 3 * R, 4 * R, 4 * R + L], axis=-1)
        o_ret = _retention(q, k, v, g, ret_gn_g[l].astype(f32))
        o_lru = _rg_lru_branch(xb, yb, lru_conv_w[l].astype(f32), lru_conv_b[l].astype(f32),
                               lru_wa[l].astype(f32), lru_ba[l].astype(f32),
                               lru_wx[l].astype(f32), lru_bx[l].astype(f32),
                               lru_lambda[l].astype(f32), lru_norm_g[l].astype(f32))
        mix = jnp.concatenate([o_ret, o_lru], axis=-1).astype(x.dtype)
        x = x + mix @ w_out[l]
        h = _rmsnorm(x, norm2_g[l])
        x = x + (jax.nn.silu(h @ ffn_w_gate[l]) * (h @ ffn_w_up[l])) @ ffn_w_down[l]
    return _rmsnorm(x, final_g)
```

```cpp
#include <hip/hip_runtime.h>
#include <hip/hip_cooperative_groups.h>
#include <cstdio>
#include <cstdint>
namespace cg = cooperative_groups;

#ifndef MEGA
#define MEGA 1
#endif

namespace pg8 {
#define PG8_LAS __attribute__((address_space(3)))
typedef unsigned short bf16_t;
typedef short bf16x8 __attribute__((ext_vector_type(8)));
typedef float f32x4 __attribute__((ext_vector_type(4)));
typedef unsigned u32x4 __attribute__((ext_vector_type(4)));
typedef unsigned u32x2 __attribute__((ext_vector_type(2)));
constexpr int BM = 256, BK = 64, HALF = 128, HTB = HALF * BK * 2  , STAGE_BYTES = 8 * HTB, NXCD = 8, WGM = 8;

__host__ __device__ __forceinline__ int lds_byte(int r, int c) { const int st = (r >> 4) * 2 + (c >> 5), rr = r & 15, cc = c & 31, ob = rr * 64 + cc * 2; return st * 1024 + (ob ^ (((ob >> 9) & 1) << 5)); }
__host__ __device__ __forceinline__ void stage_rc(int b, int& R, int& C) { const int st = b / 1024, sb = b % 1024, swz = sb ^ (((sb >> 9) & 1) << 5); R = (st >> 1) * 16 + swz / 64; C = (st & 1) * 32 + (swz % 64) / 2; }
__host__ __device__ __forceinline__ int perm32(int rho) { const int n = rho >> 4, i = rho & 15; return 8 * (i >> 2) + 4 * n + (i & 3); }

struct Unit { int pm, pn; };
struct Gemm { const bf16_t* A; const bf16_t* Bt; int M, N, K; };

struct StaticOrder {
    int nM, nN, nwg, G, c;
    __host__ __device__ void init(int M, int N, int G_, int c_) { nM = M / BM; nN = N / BM; nwg = nM * nN; G = G_; c = c_; }
    __host__ __device__ bool next(int i, Unit& u) const {
        const long L = (long)i * G + c; if (L >= nwg) return false;
        int wgid = (int)L; { const int q = nwg / NXCD, r = nwg % NXCD, xcd = wgid % NXCD, off = wgid / NXCD; wgid = (xcd < r ? xcd * (q + 1) : r * (q + 1) + (xcd - r) * q) + off; }
        const int nig = WGM * nN, gid = wgid / nig, fm = gid * WGM, gsz = (nM - fm) < WGM ? (nM - fm) : WGM;
        u.pm = fm + ((wgid % nig) % gsz); u.pn = (wgid % nig) / gsz; return true;
    }
    __device__ __forceinline__ void a_ready(const Unit&) const {}
    __device__ __forceinline__ void done(const Unit&) const {}
};

typedef __bf16 bf16x2_cv __attribute__((ext_vector_type(2)));
typedef float f32x2_cv __attribute__((ext_vector_type(2)));
__device__ __forceinline__ unsigned cvt_pk_bf16(float lo, float hi) { const f32x2_cv v = {lo, hi}; return __builtin_bit_cast(unsigned, __builtin_convertvector(v, bf16x2_cv)); }
__device__ __forceinline__ float silu_f(float g) { return g * __builtin_amdgcn_rcpf(1.0f + __expf(-g)); }

struct EpiBf16 {
    static constexpr bool PERM = true, AFTER_DRAIN = false;
    bf16_t* O; int ldc;
    __device__ __forceinline__ void operator()(const f32x4 (&acc)[2][2][4][2], const Unit& u, int wr, int wc, int fr, int fq) const {
        const int row0 = u.pm * BM + wr * 64 + fr, col0 = u.pn * BM + wc * 32 + 8 * fq;
#pragma unroll
        for (int ai = 0; ai < 2; ++ai)
#pragma unroll
            for (int m = 0; m < 4; ++m) { bf16_t* rowp = O + (size_t)(row0 + ai * HALF + m * 16) * ldc + col0;
#pragma unroll
                for (int bj = 0; bj < 2; ++bj) { const f32x4 v0 = acc[ai][bj][m][0], v1 = acc[ai][bj][m][1];
                    u32x4 w; w.x = cvt_pk_bf16(v0[0], v0[1]); w.y = cvt_pk_bf16(v0[2], v0[3]); w.z = cvt_pk_bf16(v1[0], v1[1]); w.w = cvt_pk_bf16(v1[2], v1[3]);
                    *(u32x4*)(rowp + bj * HALF) = w; } }
    }
};
struct EpiSwiglu {
    static constexpr bool PERM = true, AFTER_DRAIN = false;
    bf16_t* O; int ldc;
    __device__ __forceinline__ void operator()(const f32x4 (&acc)[2][2][4][2], const Unit& u, int wr, int wc, int fr, int fq) const {
        const int row0 = u.pm * BM + wr * 64 + fr, col0 = u.pn * HALF + wc * 32 + 8 * fq;
#pragma unroll
        for (int ai = 0; ai < 2; ++ai)
#pragma unroll
            for (int m = 0; m < 4; ++m) { bf16_t* rowp = O + (size_t)(row0 + ai * HALF + m * 16) * ldc + col0;
                const f32x4 g0 = acc[ai][0][m][0], g1 = acc[ai][0][m][1], u0 = acc[ai][1][m][0], u1 = acc[ai][1][m][1];
                u32x4 w; w.x = cvt_pk_bf16(silu_f(g0[0]) * u0[0], silu_f(g0[1]) * u0[1]); w.y = cvt_pk_bf16(silu_f(g0[2]) * u0[2], silu_f(g0[3]) * u0[3]);
                w.z = cvt_pk_bf16(silu_f(g1[0]) * u1[0], silu_f(g1[1]) * u1[1]); w.w = cvt_pk_bf16(silu_f(g1[2]) * u1[2], silu_f(g1[3]) * u1[3]);
                *(u32x4*)rowp = w; }
    }
};

template <bool FINAL> struct EpiResNorm {
    static constexpr bool PERM = false, AFTER_DRAIN = true;
    const float* R; float* C; bf16_t* HB; const float* gain; float* slots; unsigned* cnt;
    __device__ __forceinline__ void fused(f32x4 (&acc)[2][2][4][2], const Unit& u, int wr, int wc, int fr, int fq, PG8_LAS unsigned char* lds, int wid, int lane) const {
        PG8_LAS float* Pt = (PG8_LAS float*)lds;
        PG8_LAS float* Rs = Pt + 1024;
        const int row0 = u.pm * BM + wr * 64 + fr, col0 = u.pn * BM + wc * 32 + 4 * fq, ldc = 2048;
#pragma unroll
        for (int ai = 0; ai < 2; ++ai)
#pragma unroll
            for (int m = 0; m < 4; ++m) { const size_t off = (size_t)(row0 + ai * HALF + m * 16) * ldc + col0; float ss = 0.f;
#pragma unroll
                for (int bj = 0; bj < 2; ++bj)
#pragma unroll
                    for (int n = 0; n < 2; ++n) { const f32x4 r = *(const f32x4*)(R + off + bj * HALF + n * 16); const f32x4 v = r + acc[ai][bj][m][n]; acc[ai][bj][m][n] = v;
                        ss += (v[0] * v[0] + v[1] * v[1]) + (v[2] * v[2] + v[3] * v[3]); }
                ss += __shfl_xor(ss, 16); ss += __shfl_xor(ss, 32);
                if (fq == 0) Pt[(ai * HALF + wr * 64 + m * 16 + fr) * 4 + wc] = ss; }
        __syncthreads();
        const int tid = wid * 64 + lane;
        if (wid < 4) {
            const f32x4 p4 = *(const PG8_LAS f32x4*)(Pt + tid * 4);
            __hip_atomic_store(slots + (size_t)(u.pm * BM + tid) * 8 + u.pn, (p4[0] + p4[1]) + (p4[2] + p4[3]), __ATOMIC_RELAXED, __HIP_MEMORY_SCOPE_AGENT);
            asm volatile("s_waitcnt vmcnt(0)" ::: "memory");
            if (lane == 0) (void)__hip_atomic_fetch_add(cnt + 16 * u.pm, 1u, __ATOMIC_RELAXED, __HIP_MEMORY_SCOPE_AGENT);
        }
        if (wid == 0) {
            unsigned spins = 0;
            while ((unsigned)__builtin_amdgcn_readfirstlane(__hip_atomic_load(cnt + 16 * u.pm, __ATOMIC_RELAXED, __HIP_MEMORY_SCOPE_AGENT)) < 32u) { __builtin_amdgcn_s_sleep(2); if (++spins > (1u << 18)) break; }
            __builtin_amdgcn_fence(__ATOMIC_ACQUIRE, "agent");
            asm volatile("s_waitcnt vmcnt(0)" ::: "memory");
        }
        __syncthreads();
        if (wid < 4) { float t = 0.f;
#pragma unroll
            for (int k = 0; k < 8; ++k) t += __hip_atomic_load(slots + (size_t)(u.pm * BM + tid) * 8 + k, __ATOMIC_RELAXED, __HIP_MEMORY_SCOPE_AGENT);
            Rs[tid] = 1.0f / sqrtf(t * (1.0f / 2048.0f) + 1e-6f); }
        __syncthreads();
        f32x4 gv[2][2];
#pragma unroll
        for (int bj = 0; bj < 2; ++bj)
#pragma unroll
            for (int n = 0; n < 2; ++n) gv[bj][n] = *(const f32x4*)(gain + col0 + bj * HALF + n * 16);
#pragma unroll
        for (int ai = 0; ai < 2; ++ai)
#pragma unroll
            for (int m = 0; m < 4; ++m) { const size_t off = (size_t)(row0 + ai * HALF + m * 16) * ldc + col0; const float rs = Rs[ai * HALF + wr * 64 + m * 16 + fr];
#pragma unroll
                for (int bj = 0; bj < 2; ++bj)
#pragma unroll
                    for (int n = 0; n < 2; ++n) { const f32x4 v = acc[ai][bj][m][n], y = v * rs * gv[bj][n];
                        if (FINAL) { *(f32x4*)(C + off + bj * HALF + n * 16) = y; }
                        else { *(f32x4*)(C + off + bj * HALF + n * 16) = v; u32x2 w; w.x = cvt_pk_bf16(y[0], y[1]); w.y = cvt_pk_bf16(y[2], y[3]); *(u32x2*)(HB + off + bj * HALF + n * 16) = w; } } }
    }
};

template <class Epi, class Sched, bool ALIGN_EPI = false, bool SP2 = false>
__device__ __forceinline__ void gemm_phase(PG8_LAS unsigned char* lds, const Gemm g, const Sched& S, const Epi& E) {
    int tid_ = threadIdx.x; asm volatile("" : "+v"(tid_));
    const int tid = tid_, wid = __builtin_amdgcn_readfirstlane(tid >> 6), lane = tid & 63, wr = wid >> 2, wc = wid & 3, fr = lane & 15, fq = lane >> 4;
    const int K = g.K, nt = K / BK;
    unsigned voffA[2], voffB[2];
#pragma unroll
    for (int i = 0; i < 2; ++i) { int R, C; stage_rc(tid * 16 + i * 8192, R, C); const int Rb = Epi::PERM ? ((R & ~31) + perm32(R & 31)) : R;
        voffA[i] = (unsigned)(R * K + C) * 2u; voffB[i] = (unsigned)(Rb * K + C) * 2u; }
    const size_t kstep = (size_t)(BK * 2);
    const size_t hstep = (size_t)HALF * K * 2;
    const size_t tstep = 2 * hstep;
    const unsigned ldsw = (unsigned)wid * 1024u;
    const int aoff = lds_byte(wr * 64 + fr, fq * 8), boff = lds_byte(wc * 32 + fr, fq * 8);
#define PG8_SA(b, h) (((b) * 2 + (h)) * HTB)
#define PG8_SB(b, h) ((4 + (b) * 2 + (h)) * HTB)
#define PG8_STAGE(bufoff, gbase, voff) do { _Pragma("unroll") for (int _i = 0; _i < 2; ++_i) \
        __builtin_amdgcn_global_load_lds((const unsigned*)((const char*)(gbase) + (voff)[_i]), (PG8_LAS unsigned*)(lds + (bufoff) + ldsw + _i * 8192), 16, 0, 0); } while (0)
#define PG8_LDA(dst, b, h) do { _Pragma("unroll") for (int m = 0; m < 4; ++m) _Pragma("unroll") for (int k = 0; k < 2; ++k) dst[m][k] = *(const PG8_LAS bf16x8*)(lds + PG8_SA(b, h) + aoff + m * 2048 + k * 1024); } while (0)
#define PG8_LDB(dst, b, h) do { _Pragma("unroll") for (int n = 0; n < 2; ++n) _Pragma("unroll") for (int k = 0; k < 2; ++k) dst[n][k] = *(const PG8_LAS bf16x8*)(lds + PG8_SB(b, h) + boff + n * 2048 + k * 1024); } while (0)
#define PG8_MMA(ai, bj, At, Bt) do { __builtin_amdgcn_s_setprio(1); _Pragma("unroll") for (int m = 0; m < 4; ++m) _Pragma("unroll") for (int n = 0; n < 2; ++n) _Pragma("unroll") for (int k = 0; k < 2; ++k) \
        acc[ai][bj][m][n] = __builtin_amdgcn_mfma_f32_16x16x32_bf16(Bt[n][k], At[m][k], acc[ai][bj][m][n], 0, 0, 0); __builtin_amdgcn_s_setprio(0); } while (0)
#define PG8_WAIT_V(n) asm volatile("s_waitcnt vmcnt(" #n ")" ::: "memory")
#define PG8_WAIT_L(n) asm volatile("s_waitcnt lgkmcnt(" #n ")" ::: "memory")
#define PG8_BAR __builtin_amdgcn_s_barrier()
#define PG8_SCHED __builtin_amdgcn_sched_barrier(0)
    Unit cur, nxt; int ui = 0;
    if (!S.next(0, cur)) return;
    f32x4 acc[2][2][4][2];
#pragma unroll
    for (int a = 0; a < 2; ++a)
#pragma unroll
        for (int b = 0; b < 2; ++b)
#pragma unroll
            for (int m = 0; m < 4; ++m)
#pragma unroll
                for (int n = 0; n < 2; ++n) acc[a][b][m][n] = (f32x4){0.f, 0.f, 0.f, 0.f};
    bf16x8 At[4][2], B0[2][2], B1[2][2];
    const char* cA = (const char*)g.A + (size_t)cur.pm * tstep; const char* cB = (const char*)g.Bt + (size_t)cur.pn * tstep;
    S.a_ready(cur);
    if constexpr (SP2) {
        PG8_STAGE(PG8_SB(0, 0), cB, voffB); PG8_STAGE(PG8_SB(0, 1), cB + hstep, voffB); PG8_STAGE(PG8_SA(0, 0), cA, voffA); PG8_STAGE(PG8_SA(0, 1), cA + hstep, voffA);
        if (wr == 1) PG8_BAR;
        PG8_WAIT_V(2); PG8_BAR;
        PG8_STAGE(PG8_SB(1, 0), cB + kstep, voffB); PG8_STAGE(PG8_SA(1, 0), cA + kstep, voffA); PG8_STAGE(PG8_SB(1, 1), cB + hstep + kstep, voffB);
        PG8_WAIT_V(6); PG8_BAR;
    } else {
        PG8_STAGE(PG8_SB(0, 0), cB, voffB); PG8_STAGE(PG8_SA(0, 0), cA, voffA); PG8_STAGE(PG8_SB(0, 1), cB + hstep, voffB); PG8_STAGE(PG8_SA(0, 1), cA + hstep, voffA);
        if (wr == 1) PG8_BAR;
        PG8_WAIT_V(4); PG8_BAR;
        PG8_STAGE(PG8_SB(1, 0), cB + kstep, voffB); PG8_STAGE(PG8_SA(1, 0), cA + kstep, voffA); PG8_STAGE(PG8_SB(1, 1), cB + hstep + kstep, voffB);
        PG8_WAIT_V(6); PG8_BAR;
    }
    for (;;) {
        const bool has_next = S.next(ui + 1, nxt);
        const char* nA = has_next ? (const char*)g.A + (size_t)nxt.pm * tstep : cA; const char* nB = has_next ? (const char*)g.Bt + (size_t)nxt.pn * tstep : cB;
        for (int t = 0; t < nt; t += 2) {
            const bool last = (t == nt - 2);
            const char* a1 = cA + (size_t)(t + 1) * kstep;
            const char* a2 = last ? nA : cA + (size_t)(t + 2) * kstep; const char* b2 = last ? nB : cB + (size_t)(t + 2) * kstep;
            const char* a3 = a2 + kstep; const char* b3 = b2 + kstep;
            if (last && has_next) S.a_ready(nxt);
            if constexpr (SP2) {
            PG8_LDB(B0, 0, 0); PG8_LDB(B1, 0, 1); PG8_SCHED; PG8_LDA(At, 0, 0); PG8_STAGE(PG8_SA(1, 1), a1 + hstep, voffA);
            PG8_WAIT_V(8); PG8_WAIT_L(0); PG8_BAR; PG8_MMA(0, 0, At, B0); PG8_MMA(0, 1, At, B1); PG8_BAR; PG8_SCHED;
            PG8_LDA(At, 0, 1); PG8_STAGE(PG8_SB(0, 0), b2, voffB); PG8_STAGE(PG8_SB(0, 1), b2 + hstep, voffB); PG8_STAGE(PG8_SA(0, 0), a2, voffA);
            PG8_WAIT_V(8); PG8_WAIT_L(0); PG8_BAR; PG8_MMA(1, 0, At, B0); PG8_MMA(1, 1, At, B1); PG8_BAR; PG8_SCHED;
            PG8_LDB(B0, 1, 0); PG8_LDB(B1, 1, 1); PG8_SCHED; PG8_LDA(At, 1, 0); PG8_STAGE(PG8_SA(0, 1), a2 + hstep, voffA);
            PG8_WAIT_V(8); PG8_WAIT_L(0); PG8_BAR; PG8_MMA(0, 0, At, B0); PG8_MMA(0, 1, At, B1); PG8_BAR; PG8_SCHED;
            PG8_LDA(At, 1, 1); PG8_STAGE(PG8_SB(1, 0), b3, voffB); PG8_STAGE(PG8_SB(1, 1), b3 + hstep, voffB); PG8_STAGE(PG8_SA(1, 0), a3, voffA);
            PG8_WAIT_V(8); PG8_WAIT_L(0); PG8_BAR; PG8_MMA(1, 0, At, B0); PG8_MMA(1, 1, At, B1); PG8_BAR; PG8_SCHED;
            } else {
            PG8_LDB(B0, 0, 0); PG8_SCHED; PG8_LDA(At, 0, 0); PG8_STAGE(PG8_SA(1, 1), a1 + hstep, voffA);
            PG8_WAIT_L(8); PG8_BAR; PG8_WAIT_L(0); PG8_MMA(0, 0, At, B0); PG8_BAR; PG8_SCHED;
            PG8_LDB(B1, 0, 1); PG8_STAGE(PG8_SB(0, 0), b2, voffB);
            PG8_BAR; PG8_WAIT_L(0); PG8_MMA(0, 1, At, B1); PG8_BAR;
            PG8_LDA(At, 0, 1); PG8_STAGE(PG8_SA(0, 0), a2, voffA);
            PG8_BAR; PG8_WAIT_L(0); PG8_MMA(1, 0, At, B0); PG8_BAR; PG8_SCHED;
            PG8_STAGE(PG8_SB(0, 1), b2 + hstep, voffB);
            PG8_WAIT_V(6); PG8_BAR; PG8_MMA(1, 1, At, B1); PG8_BAR;
            PG8_LDB(B0, 1, 0); PG8_SCHED; PG8_LDA(At, 1, 0); PG8_STAGE(PG8_SA(0, 1), a2 + hstep, voffA);
            PG8_WAIT_L(8); PG8_BAR; PG8_WAIT_L(0); PG8_MMA(0, 0, At, B0); PG8_BAR; PG8_SCHED;
            PG8_LDB(B1, 1, 1); PG8_STAGE(PG8_SB(1, 0), b3, voffB);
            PG8_BAR; PG8_WAIT_L(0); PG8_MMA(0, 1, At, B1); PG8_BAR;
            PG8_LDA(At, 1, 1); PG8_STAGE(PG8_SA(1, 0), a3, voffA);
            PG8_BAR; PG8_WAIT_L(0); PG8_MMA(1, 0, At, B0); PG8_BAR; PG8_SCHED;
            PG8_STAGE(PG8_SB(1, 1), b3 + hstep, voffB);
            PG8_WAIT_V(6); PG8_BAR; PG8_MMA(1, 1, At, B1); PG8_BAR;
            }
        }
        if constexpr (ALIGN_EPI) { if (wr == 0) PG8_BAR; }
        if constexpr (!Epi::AFTER_DRAIN) { E(acc, cur, wr, wc, fr, fq); S.done(cur); }
        if (!has_next) break;
#pragma unroll
        for (int a = 0; a < 2; ++a)
#pragma unroll
            for (int b = 0; b < 2; ++b)
#pragma unroll
                for (int m = 0; m < 4; ++m)
#pragma unroll
                    for (int n = 0; n < 2; ++n) acc[a][b][m][n] = (f32x4){0.f, 0.f, 0.f, 0.f};
        cur = nxt; cA = nA; cB = nB; ++ui;
        if constexpr (ALIGN_EPI) { if (wr == 1) PG8_BAR; }
    }
    PG8_WAIT_V(0);
    if constexpr (!ALIGN_EPI) { if (wr == 0) PG8_BAR; }
    PG8_BAR;
    if constexpr (Epi::AFTER_DRAIN) { E.fused(acc, cur, wr, wc, fr, fq, lds, wid, lane); S.done(cur); }
#undef PG8_SA
#undef PG8_SB
#undef PG8_STAGE
#undef PG8_LDA
#undef PG8_LDB
#undef PG8_MMA
#undef PG8_WAIT_V
#undef PG8_WAIT_L
#undef PG8_BAR
#undef PG8_SCHED
}
}

#define LAS __attribute__((address_space(3)))
typedef unsigned short bf16_t;
typedef float f32x4 __attribute__((ext_vector_type(4)));
typedef unsigned u32x4 __attribute__((ext_vector_type(4)));
typedef unsigned u32x2 __attribute__((ext_vector_type(2)));
constexpr int DM = 2048, SEQ = 2048, MTOK = 8192, DEPTH = 2;
constexpr int RH = 8, RW = 1024, LW = 1024, INW = 6144, DFF = 5632, NCH = 32;
constexpr float EPS = 1e-6f;
constexpr int NT = 512;
constexpr int LDS_BYTES = 136 * 1024;

constexpr size_t MiB = 1u << 20;
constexpr size_t WS_ROPE = 0;
constexpr size_t WS_WIN = 1 * MiB;
constexpr size_t WS_WOUT = 25 * MiB;
constexpr size_t WS_WGU = 33 * MiB;
constexpr size_t WS_WDN = 77 * MiB;
constexpr size_t WS_P = 99 * MiB;
constexpr size_t WS_U = 195 * MiB;
constexpr size_t WS_MIX = 259 * MiB;
constexpr size_t WS_H = 291 * MiB;
constexpr size_t WS_HL = 323 * MiB;
constexpr size_t WS_ACUM = 355 * MiB;
constexpr size_t WS_APROD = 387 * MiB;
constexpr size_t WS_HEND = 387 * MiB + 512 * 1024;
constexpr size_t WS_BAR = 388 * MiB;
constexpr size_t WS_CARRY = 389 * MiB;
constexpr size_t WS_WAT = 389 * MiB + 512 * 1024;
constexpr size_t WS_SB = 390 * MiB;
constexpr size_t WS_SLOTS = 422 * MiB;
constexpr size_t WS_CNT = 423 * MiB;
constexpr size_t WS_END = 424 * MiB;

__device__ __forceinline__ float bf2f(bf16_t v) { return __uint_as_float((unsigned)v << 16); }
typedef __bf16 bf16x2_hw __attribute__((ext_vector_type(2)));
typedef float f32x2_hw __attribute__((ext_vector_type(2)));
__device__ __forceinline__ unsigned pk2(float lo, float hi) { const f32x2_hw v = {lo, hi}; return __builtin_bit_cast(unsigned, __builtin_convertvector(v, bf16x2_hw)); }
__device__ __forceinline__ unsigned f2bf(float f) { return pk2(f, 0.f) & 0xffffu; }
__device__ __forceinline__ float wave_sum(float v) {
#pragma unroll
    for (int o = 1; o < 64; o <<= 1) v += __shfl_xor(v, o);
    return v;
}
__device__ __forceinline__ float sigmoid_f(float x) { return 1.0f / (1.0f + __expf(-x)); }
__device__ __forceinline__ float gelu_tanh_f(float x) {
    const float u = 0.7978845608028654f * (x + 0.044715f * x * x * x);
    const float t = 1.0f - 2.0f / (1.0f + __expf(2.0f * u));
    return 0.5f * x * (1.0f + t);
}

struct Args { const float* in[18]; float* out; unsigned char* ws; int ph_lo, ph_hi; };

__device__ __forceinline__ void transpose_item(const float* W, int K, int N, bf16_t* WT, int k0, int n0, int dst_row0, LAS float* scr, int lane) {
    const int kk = lane >> 4, n4 = (lane & 15) * 4; f32x4 v[16];
#pragma unroll
    for (int i = 0; i < 16; ++i) v[i] = *(const f32x4*)(W + (size_t)(k0 + kk + 4 * i) * N + n0 + n4);
#pragma unroll
    for (int i = 0; i < 16; ++i) { LAS float* d = scr + (kk + 4 * i) * 65 + n4; d[0] = v[i][0]; d[1] = v[i][1]; d[2] = v[i][2]; d[3] = v[i][3]; }
    asm volatile("s_waitcnt lgkmcnt(0)" ::: "memory");
    const int c = lane & 7;
#pragma unroll
    for (int j = 0; j < 8; ++j) { const int n = (lane >> 3) + 8 * j; const LAS float* s = scr + (8 * c) * 65 + n;
        u32x4 o; o.x = pk2(s[0 * 65], s[1 * 65]); o.y = pk2(s[2 * 65], s[3 * 65]); o.z = pk2(s[4 * 65], s[5 * 65]); o.w = pk2(s[6 * 65], s[7 * 65]);
        *(u32x4*)(WT + (size_t)(dst_row0 + n) * K + k0 + 8 * c) = o; }
    asm volatile("s_waitcnt lgkmcnt(0)" ::: "memory");
}
__device__ __forceinline__ void convert_weights(const Args& a, int l, LAS unsigned char* lds, int gw, int NGW, int wave, int lane, int part) {
    LAS float* scr = (LAS float*)(lds + wave * 16640);
    const float* w_in = a.in[2] + (size_t)l * DM * INW; const float* w_out = a.in[12] + (size_t)l * DM * DM;
    const float* w_g = a.in[14] + (size_t)l * DM * DFF; const float* w_u = a.in[15] + (size_t)l * DM * DFF; const float* w_d = a.in[16] + (size_t)l * DFF * DM;
    bf16_t* WIN = (bf16_t*)(a.ws + WS_WIN); bf16_t* WOUT = (bf16_t*)(a.ws + WS_WOUT); bf16_t* WGU = (bf16_t*)(a.ws + WS_WGU); bf16_t* WDN = (bf16_t*)(a.ws + WS_WDN);
    constexpr int I_IN = (DM / 64) * (INW / 64), I_OUT = (DM / 64) * (DM / 64), I_G = (DM / 64) * (DFF / 64), I_D = (DFF / 64) * (DM / 64);
    constexpr int NITEMS = I_IN + I_OUT + 2 * I_G + I_D;
    const int it_lo = part == 2 ? I_IN + I_OUT : 0, it_hi = part == 1 ? I_IN + I_OUT : NITEMS;
    for (int it = it_lo + gw; it < it_hi; it += NGW) {
        int r = it; const float* W; bf16_t* WT; int K, N, dsel;
        if (r < I_IN) { W = w_in; WT = WIN; K = DM; N = INW; dsel = 0; }
        else if ((r -= I_IN) < I_OUT) { W = w_out; WT = WOUT; K = DM; N = DM; dsel = 0; }
        else if ((r -= I_OUT) < I_G) { W = w_g; WT = WGU; K = DM; N = DFF; dsel = 1; }
        else if ((r -= I_G) < I_G) { W = w_u; WT = WGU; K = DM; N = DFF; dsel = 2; }
        else { r -= I_G; W = w_d; WT = WDN; K = DFF; N = DM; dsel = 0; }
        const int nb = N / 64, kb = r / nb, n0 = (r % nb) * 64;
        const int dst = dsel == 0 ? n0 : (n0 >> 7) * 256 + (n0 & 127) + (dsel == 2 ? 128 : 0);
        transpose_item(W, K, N, WT, kb * 64, n0, dst, scr, lane);
    }
}
template <bool OUT_F32>
__device__ __forceinline__ void rmsnorm_rows(const float* X, const float* g, void* outp, int gw, int NGW, int lane) {
    f32x4 gv[8];
#pragma unroll
    for (int j = 0; j < 8; ++j) gv[j] = *(const f32x4*)(g + j * 256 + lane * 4);
    for (int m = gw; m < MTOK; m += NGW) {
        const float* xr = X + (size_t)m * DM; f32x4 v[8]; float s = 0.f;
#pragma unroll
        for (int j = 0; j < 8; ++j) { v[j] = *(const f32x4*)(xr + j * 256 + lane * 4); s += (v[j][0] * v[j][0] + v[j][1] * v[j][1]) + (v[j][2] * v[j][2] + v[j][3] * v[j][3]); }
        const float rs = 1.0f / sqrtf(wave_sum(s) * (1.0f / DM) + EPS);
        if (OUT_F32) { float* o = (float*)outp + (size_t)m * DM;
#pragma unroll
            for (int j = 0; j < 8; ++j) *(f32x4*)(o + j * 256 + lane * 4) = v[j] * rs * gv[j];
        } else { bf16_t* o = (bf16_t*)outp + (size_t)m * DM;
#pragma unroll
            for (int j = 0; j < 8; ++j) { const f32x4 y = v[j] * rs * gv[j]; u32x2 w; w.x = pk2(y[0], y[1]); w.y = pk2(y[2], y[3]); *(u32x2*)(o + j * 256 + lane * 4) = w; } }
    }
}
__device__ __forceinline__ void rope_table(float2* tab, int gtid, int NG) {
    for (int i = gtid; i < SEQ * 64; i += NG) { const int t = i >> 6, d = i & 63;
        const float inv = 1.0f / powf(10000.0f, (float)d * (1.0f / 64.0f)); const float ang = (float)t * inv;
        const double rev = (double)ang * 0.15915494309189535; const float fr = (float)(rev - floor(rev));
        tab[i] = make_float2(__builtin_amdgcn_cosf(fr), __builtin_amdgcn_sinf(fr)); }
}

typedef short bf16x8_t __attribute__((ext_vector_type(8)));
__device__ __forceinline__ unsigned off_b(unsigned row, unsigned ch) { return 256u * row + 16u * (ch ^ (((row & 3u) << 2) | ((row >> 2) & 3u))); }
typedef short s16x4 __attribute__((ext_vector_type(4)));
__device__ __forceinline__ unsigned tr_addr(unsigned R0, unsigned c, unsigned fr) { const unsigned q = fr >> 2, p = fr & 3; return off_b(R0 + q, 2 * c + (p >> 1)) + 8 * (p & 1); }
#define TR_READ2(d0, d1, a0, a1) asm volatile("ds_read_b64_tr_b16 %0, %2\n\tds_read_b64_tr_b16 %1, %3\n\ts_waitcnt lgkmcnt(0)" : "=&v"(d0), "=&v"(d1) : "v"(a0), "v"(a1) : "memory")
#define TR_READ4(d0, d1, d2, d3, a0, a1, a2, a3) asm volatile("ds_read_b64_tr_b16 %0, %4\n\tds_read_b64_tr_b16 %1, %5\n\tds_read_b64_tr_b16 %2, %6\n\tds_read_b64_tr_b16 %3, %7\n\ts_waitcnt lgkmcnt(0)" \
    : "=&v"(d0), "=&v"(d1), "=&v"(d2), "=&v"(d3) : "v"(a0), "v"(a1), "v"(a2), "v"(a3) : "memory")
template <int CTRL> __device__ __forceinline__ float dppf(float v) { return __int_as_float(__builtin_amdgcn_update_dpp(0, __float_as_int(v), CTRL, 0xf, 0xf, true)); }
__device__ __forceinline__ float row16_sum(float v) { v += dppf<0xB1>(v); v += dppf<0x4E>(v); v += dppf<0x141>(v); v += dppf<0x140>(v); return v; }
__device__ __forceinline__ bf16x8_t cat4(s16x4 a, s16x4 b) { return (bf16x8_t){a[0], a[1], a[2], a[3], b[0], b[1], b[2], b[3]}; }
__device__ __forceinline__ float ret_logg(int h) { return log1pf(-exp2f(-5.0f - (float)h)); }
__device__ __forceinline__ float bflo(unsigned w) { return __uint_as_float(w << 16); }
__device__ __forceinline__ float bfhi(unsigned w) { return __uint_as_float(w & 0xffff0000u); }
__device__ __forceinline__ void rope_apply(const u32x4 lo, const u32x4 hi, const f32x4 (&cs)[4], LAS unsigned char* img, int c, int ch, float scale) {
    float t1[8] = {bflo(lo.x), bfhi(lo.x), bflo(lo.y), bfhi(lo.y), bflo(lo.z), bfhi(lo.z), bflo(lo.w), bfhi(lo.w)};
    float t2[8] = {bflo(hi.x), bfhi(hi.x), bflo(hi.y), bfhi(hi.y), bflo(hi.z), bfhi(hi.z), bflo(hi.w), bfhi(hi.w)};
    float o1[8], o2[8];
#pragma unroll
    for (int k = 0; k < 4; ++k) {
        o1[2 * k] = (t1[2 * k] * cs[k][0] - t2[2 * k] * cs[k][1]) * scale; o2[2 * k] = (t1[2 * k] * cs[k][1] + t2[2 * k] * cs[k][0]) * scale;
        o1[2 * k + 1] = (t1[2 * k + 1] * cs[k][2] - t2[2 * k + 1] * cs[k][3]) * scale; o2[2 * k + 1] = (t1[2 * k + 1] * cs[k][3] + t2[2 * k + 1] * cs[k][2]) * scale; }
    u32x4 w1, w2; w1.x = pk2(o1[0], o1[1]); w1.y = pk2(o1[2], o1[3]); w1.z = pk2(o1[4], o1[5]); w1.w = pk2(o1[6], o1[7]);
    w2.x = pk2(o2[0], o2[1]); w2.y = pk2(o2[2], o2[3]); w2.z = pk2(o2[4], o2[5]); w2.w = pk2(o2[6], o2[7]);
    *(LAS u32x4*)(img + off_b(c, ch)) = w1; *(LAS u32x4*)(img + off_b(c, ch + 8)) = w2;
}
struct R1Regs { u32x4 klo, khi, v[2]; f32x4 cs[4]; };
__device__ __forceinline__ void ret1_load(R1Regs& r, const bf16_t* P, const float2* rope, int item, int tid) {
    const int b = item >> 8, n = (item >> 3) & 31, h = item & 7, row0 = b * SEQ + n * 64, c = tid >> 3, ch = tid & 7;
    const bf16_t* src = P + (size_t)(row0 + c) * INW + 1024 + h * 128; r.klo = *(const u32x4*)(src + 8 * ch); r.khi = *(const u32x4*)(src + 64 + 8 * ch);
    const float2* rp = rope + (n * 64 + c) * 64;
#pragma unroll
    for (int k = 0; k < 4; ++k) r.cs[k] = *(const f32x4*)(rp + 8 * ch + 2 * k);
#pragma unroll
    for (int k = 0; k < 2; ++k) { const int i = tid + NT * k; r.v[k] = *(const u32x4*)(P + (size_t)(row0 + (i >> 4)) * INW + 2048 + h * 128 + 8 * (i & 15)); }
}
__device__ __forceinline__ void ret_stage1_block(const Args& a, LAS unsigned char* lds, int bid, int G, int tid) {
    const bf16_t* P = (const bf16_t*)(a.ws + WS_P); const float2* rope = (const float2*)(a.ws + WS_ROPE); bf16_t* U = (bf16_t*)(a.ws + WS_U);
    LAS unsigned char* Ki = lds; LAS unsigned char* Vi = lds + 16384;
    const int lane = tid & 63, wave = tid >> 6, fr = lane & 15, fq = lane >> 4;
    const unsigned kb = (unsigned)(size_t)Ki, vb = (unsigned)(size_t)Vi;
    R1Regs rg;
    if (bid < 1024) ret1_load(rg, P, rope, bid, tid);
    for (int item = bid; item < 1024; item += G) {
        const int b = item >> 8, n = (item >> 3) & 31, h = item & 7; const float lg = ret_logg(h);
        { const int c = tid >> 3, ch = tid & 7; rope_apply(rg.klo, rg.khi, rg.cs, Ki, c, ch, 0.08838834764831845f * __expf(lg * (float)(63 - c)));
#pragma unroll
          for (int k = 0; k < 2; ++k) { const int i = tid + NT * k; *(LAS u32x4*)(Vi + off_b(i >> 4, i & 15)) = rg.v[k]; } }
        __syncthreads();
        if (item + G < 1024) ret1_load(rg, P, rope, item + G, tid);
        bf16x8_t af[2];
        { s16x4 x0, x1, x2, x3; TR_READ4(x0, x1, x2, x3, kb + tr_addr(8 * fq, wave, fr), kb + tr_addr(8 * fq + 4, wave, fr), kb + tr_addr(32 + 8 * fq, wave, fr), kb + tr_addr(32 + 8 * fq + 4, wave, fr)); af[0] = cat4(x0, x1); af[1] = cat4(x2, x3); }
        bf16_t* up = U + (size_t)((b * 8 + h) * 32 + n) * 16384 + (size_t)(16 * wave + fr) * 128 + 4 * fq;
#pragma unroll
        for (int eb = 0; eb < 8; ++eb) { f32x4 acc = (f32x4){0.f, 0.f, 0.f, 0.f};
            { s16x4 x0, x1, x2, x3; TR_READ4(x0, x1, x2, x3, vb + tr_addr(8 * fq, eb, fr), vb + tr_addr(8 * fq + 4, eb, fr), vb + tr_addr(32 + 8 * fq, eb, fr), vb + tr_addr(32 + 8 * fq + 4, eb, fr));
                acc = __builtin_amdgcn_mfma_f32_16x16x32_bf16(cat4(x0, x1), af[0], acc, 0, 0, 0); acc = __builtin_amdgcn_mfma_f32_16x16x32_bf16(cat4(x2, x3), af[1], acc, 0, 0, 0); }
            u32x2 w; w.x = pk2(acc[0], acc[1]); w.y = pk2(acc[2], acc[3]); *(u32x2*)(up + 16 * eb) = w; }
        __syncthreads();
    }
}
__device__ __forceinline__ void ret_scan(const Args& a, int gtid, int NG) {
    const u32x2* U4 = (const u32x2*)(a.ws + WS_U); u32x2* S2 = (u32x2*)(a.ws + WS_SB);
    for (int i = gtid; i < 32 * 4096; i += NG) { const int bh = i >> 12, q = i & 4095, h = bh & 7; const float dec = __expf(64.0f * ret_logg(h));
        const u32x2* ub = U4 + (size_t)bh * 32 * 4096 + q; u32x2* sb = S2 + (size_t)bh * 32 * 4096 + q; f32x4 s = (f32x4){0.f, 0.f, 0.f, 0.f};
#pragma unroll
        for (int nb = 0; nb < 32; nb += 16) { u32x2 uv[16];
#pragma unroll
            for (int n = 0; n < 16; ++n) uv[n] = ub[(size_t)(nb + n) * 4096];
#pragma unroll
            for (int n = 0; n < 16; ++n) { const f32x4 u = (f32x4){bflo(uv[n].x), bfhi(uv[n].x), bflo(uv[n].y), bfhi(uv[n].y)}; u32x2 w; w.x = pk2(s[0], s[1]); w.y = pk2(s[2], s[3]); sb[(size_t)(nb + n) * 4096] = w; s = s * dec + u; } } }
}
struct R3Regs { u32x4 qlo, qhi, klo, khi, v[2], sv[4]; f32x4 cs[4]; };
__device__ __forceinline__ void ret3_load(R3Regs& r, const bf16_t* P, const float2* rope, const bf16_t* SB, int item, int tid) {
    const int b = item >> 8, n = (item >> 3) & 31, h = item & 7, row0 = b * SEQ + n * 64, c = tid >> 3, ch = tid & 7;
    const bf16_t* pr = P + (size_t)(row0 + c) * INW + h * 128;
    r.qlo = *(const u32x4*)(pr + 8 * ch); r.qhi = *(const u32x4*)(pr + 64 + 8 * ch); r.klo = *(const u32x4*)(pr + 1024 + 8 * ch); r.khi = *(const u32x4*)(pr + 1024 + 64 + 8 * ch);
    const float2* rp = rope + (n * 64 + c) * 64;
#pragma unroll
    for (int k = 0; k < 4; ++k) r.cs[k] = *(const f32x4*)(rp + 8 * ch + 2 * k);
#pragma unroll
    for (int k = 0; k < 2; ++k) { const int i = tid + NT * k; const bf16_t* vr = P + (size_t)(row0 + (i >> 4)) * INW + h * 128 + 8 * (i & 15); r.v[k] = *(const u32x4*)(vr + 2048); }
    const bf16_t* sp = SB + (size_t)((b * 8 + h) * 32 + n) * 16384;
#pragma unroll
    for (int k = 0; k < 4; ++k) { const int i = tid + NT * k; r.sv[k] = *(const u32x4*)(sp + (size_t)(i >> 4) * 128 + 8 * (i & 15)); }
}
__device__ __forceinline__ void ret_stage3_block(const Args& a, int l, LAS unsigned char* lds, int bid, int G, int tid) {
    const bf16_t* P = (const bf16_t*)(a.ws + WS_P); const float2* rope = (const float2*)(a.ws + WS_ROPE); const bf16_t* SB = (const bf16_t*)(a.ws + WS_SB);
    bf16_t* MIX = (bf16_t*)(a.ws + WS_MIX); const float* gn_g = a.in[3] + l * RW;
    LAS unsigned char* Qi = lds; LAS unsigned char* Ki = lds + 16384; LAS unsigned char* Vi = lds + 32768; LAS unsigned char* Si = lds + 49152; LAS float* part = (LAS float*)(lds + 81920);
    const int lane = tid & 63, wave = tid >> 6, fr = lane & 15, fq = lane >> 4;
    R3Regs rg;
    if (bid < 1024) ret3_load(rg, P, rope, SB, bid, tid);
  for (int item = bid; item < 1024; item += G) {
    const int b = item >> 8, n = (item >> 3) & 31, h = item & 7, row0 = b * SEQ + n * 64; const float lg = ret_logg(h);
    { const int c = tid >> 3, ch = tid & 7; rope_apply(rg.qlo, rg.qhi, rg.cs, Qi, c, ch, 1.0f); rope_apply(rg.klo, rg.khi, rg.cs, Ki, c, ch, 0.08838834764831845f);
#pragma unroll
      for (int k = 0; k < 2; ++k) { const int i = tid + NT * k; *(LAS u32x4*)(Vi + off_b(i >> 4, i & 15)) = rg.v[k]; }
#pragma unroll
      for (int k = 0; k < 4; ++k) { const int i = tid + NT * k; *(LAS u32x4*)(Si + off_b(i >> 4, i & 15)) = rg.sv[k]; } }
    __syncthreads();
    u32x4 gpre[2];
#pragma unroll
    for (int k = 0; k < 2; ++k) { const int i = tid + NT * k; gpre[k] = *(const u32x4*)(P + (size_t)(row0 + (i >> 4)) * INW + 3072 + h * 128 + 8 * (i & 15)); }
    if (item + G < 1024) ret3_load(rg, P, rope, SB, item + G, tid);
    const int ab = wave & 3, eh = wave >> 2;
    const unsigned vb = (unsigned)(size_t)Vi, sbs = (unsigned)(size_t)Si;
    bf16x8_t qf[4];
#pragma unroll
    for (int ks = 0; ks < 4; ++ks) qf[ks] = *(const LAS bf16x8_t*)(Qi + off_b(16 * ab + fr, 4 * ks + fq));
    unsigned sp[4][2];
#pragma unroll
    for (int cb = 0; cb < 4; ++cb) { f32x4 acc = (f32x4){0.f, 0.f, 0.f, 0.f};
#pragma unroll
        for (int ks = 0; ks < 4; ++ks) { const bf16x8_t kf = *(const LAS bf16x8_t*)(Ki + off_b(16 * cb + fr, 4 * ks + fq)); acc = __builtin_amdgcn_mfma_f32_16x16x32_bf16(kf, qf[ks], acc, 0, 0, 0); }
        float d[4];
#pragma unroll
        for (int r = 0; r < 4; ++r) d[r] = acc[r] * __expf(lg * fabsf((float)(16 * ab + fr - (16 * cb + 4 * fq + r))));
        sp[cb][0] = pk2(d[0], d[1]); sp[cb][1] = pk2(d[2], d[3]); }
    f32x4 oi[4], oc[4];
#pragma unroll
    for (int e = 0; e < 4; ++e) { const int eb = 4 * eh + e; oi[e] = (f32x4){0.f, 0.f, 0.f, 0.f}; oc[e] = (f32x4){0.f, 0.f, 0.f, 0.f};
        {
            s16x4 x0, x1, x2, x3; TR_READ4(x0, x1, x2, x3, vb + tr_addr(4 * fq, eb, fr), vb + tr_addr(16 + 4 * fq, eb, fr), vb + tr_addr(32 + 4 * fq, eb, fr), vb + tr_addr(48 + 4 * fq, eb, fr));
            u32x4 aw; aw.x = sp[0][0]; aw.y = sp[0][1]; aw.z = sp[1][0]; aw.w = sp[1][1];
            oi[e] = __builtin_amdgcn_mfma_f32_16x16x32_bf16(__builtin_bit_cast(bf16x8_t, aw), cat4(x0, x1), oi[e], 0, 0, 0);
            aw.x = sp[2][0]; aw.y = sp[2][1]; aw.z = sp[3][0]; aw.w = sp[3][1];
            oi[e] = __builtin_amdgcn_mfma_f32_16x16x32_bf16(__builtin_bit_cast(bf16x8_t, aw), cat4(x2, x3), oi[e], 0, 0, 0); }
#pragma unroll
        for (int kp = 0; kp < 2; ++kp) { s16x4 x0, x1, x2, x3;
            TR_READ4(x0, x1, x2, x3, sbs + tr_addr(64 * kp + 8 * fq, eb, fr), sbs + tr_addr(64 * kp + 8 * fq + 4, eb, fr), sbs + tr_addr(64 * kp + 32 + 8 * fq, eb, fr), sbs + tr_addr(64 * kp + 32 + 8 * fq + 4, eb, fr));
            oc[e] = __builtin_amdgcn_mfma_f32_16x16x32_bf16(qf[2 * kp], cat4(x0, x1), oc[e], 0, 0, 0);
            oc[e] = __builtin_amdgcn_mfma_f32_16x16x32_bf16(qf[2 * kp + 1], cat4(x2, x3), oc[e], 0, 0, 0); } }
    float s1[4], s2[4];
#pragma unroll
    for (int r = 0; r < 4; ++r) { const float qd = __expf(lg * (float)(16 * ab + 4 * fq + r + 1)); s1[r] = 0.f; s2[r] = 0.f;
#pragma unroll
        for (int e = 0; e < 4; ++e) { const float v = oi[e][r] + qd * oc[e][r]; oi[e][r] = v; s1[r] += v; s2[r] += v * v; } }
#pragma unroll
    for (int r = 0; r < 4; ++r) { s1[r] = row16_sum(s1[r]); s2[r] = row16_sum(s2[r]);
        if (fr == 0) { part[(eh * 64 + 16 * ab + 4 * fq + r) * 2] = s1[r]; part[(eh * 64 + 16 * ab + 4 * fq + r) * 2 + 1] = s2[r]; } }
    __syncthreads();
    LAS bf16_t* Y = (LAS bf16_t*)lds;
    float gnv[4];
#pragma unroll
    for (int e = 0; e < 4; ++e) gnv[e] = gn_g[h * 128 + 16 * (4 * eh + e) + fr];
#pragma unroll
    for (int r = 0; r < 4; ++r) { const int aa = 16 * ab + 4 * fq + r;
        const float t1 = part[aa * 2] + part[(64 + aa) * 2], t2 = part[aa * 2 + 1] + part[(64 + aa) * 2 + 1];
        const float mu = t1 * (1.0f / 128.0f), var = fmaxf(t2 * (1.0f / 128.0f) - mu * mu, 0.f), rstd = 1.0f / sqrtf(var + EPS);
#pragma unroll
        for (int e = 0; e < 4; ++e) Y[aa * 136 + 16 * (4 * eh + e) + fr] = (bf16_t)f2bf((oi[e][r] - mu) * rstd * gnv[e]); }
    __syncthreads();
#pragma unroll
    for (int k = 0; k < 2; ++k) { const int c = tid + NT * k, row = c >> 4, ch = c & 15;
        const u32x4 yv = *(const LAS u32x4*)(Y + row * 136 + 8 * ch); const u32x4 gv = gpre[k]; u32x4 w;
        w.x = pk2(bflo(yv.x) * pg8::silu_f(bflo(gv.x)), bfhi(yv.x) * pg8::silu_f(bfhi(gv.x))); w.y = pk2(bflo(yv.y) * pg8::silu_f(bflo(gv.y)), bfhi(yv.y) * pg8::silu_f(bfhi(gv.y)));
        w.z = pk2(bflo(yv.z) * pg8::silu_f(bflo(gv.z)), bfhi(yv.z) * pg8::silu_f(bfhi(gv.z))); w.w = pk2(bflo(yv.w) * pg8::silu_f(bflo(gv.w)), bfhi(yv.w) * pg8::silu_f(bfhi(gv.w)));
        *(u32x4*)(MIX + (size_t)(row0 + row) * DM + h * 128 + 8 * ch) = w; }
    __syncthreads();
  }
}

__device__ __forceinline__ void lru_gate_weights(const Args& a, int gtid, int NG) {
    bf16_t* WAT = (bf16_t*)(a.ws + WS_WAT);
    for (int idx = gtid; idx < 2 * 16 * 2 * 4096; idx += NG) { const int i = idx & 63, j = (idx >> 6) & 63, gate = (idx >> 12) & 1, lg = idx >> 13;
        const float* w = (gate ? a.in[8] : a.in[6]) + (size_t)lg * 4096; WAT[idx] = (bf16_t)f2bf(w[i * 64 + j]); }
}
constexpr int XBS = 72;
__device__ __forceinline__ void lru_stage1_block(const Args& a, int l, LAS unsigned char* lds, int bid, int G, int tid) {
    const bf16_t* P = (const bf16_t*)(a.ws + WS_P);
    bf16_t* HL = (bf16_t*)(a.ws + WS_HL); bf16_t* ACUM = (bf16_t*)(a.ws + WS_ACUM); float* APROD = (float*)(a.ws + WS_APROD); float* HEND = (float*)(a.ws + WS_HEND);
    const float* conv_w = a.in[4] + l * 4 * LW; const float* conv_b = a.in[5] + l * LW; const float* ba = a.in[7] + l * LW; const float* bx = a.in[9] + l * LW; const float* lam = a.in[10] + l * LW;
    const bf16_t* WAT = (const bf16_t*)(a.ws + WS_WAT) + (size_t)l * 16 * 2 * 4096;
    LAS bf16_t* XB = (LAS bf16_t*)lds;
    LAS bf16_t* WT = XB + 64 * XBS;
    LAS float* XF = (LAS float*)(WT + 2 * 64 * XBS);
    LAS float* As = XF + 64 * 65; LAS float* Bs = As + 64 * 65; LAS float* segP = Bs + 64 * 65; LAS float* segH = segP + 512;
    const int lane = tid & 63, wave = tid >> 6, fr = lane & 15, fq = lane >> 4;
    const int per = (2048 + G - 1) / G; const int it_end = (bid + 1) * per < 2048 ? (bid + 1) * per : 2048;
    int gl = -1, gc = -1; float spv[2] = {0.f, 0.f}, bav[2] = {0.f, 0.f}, bxv[2] = {0.f, 0.f};
    const int j4 = (tid & 15) * 4;
    u32x2 xr[2][4];
#define LRU_LOADX(IT) do { const int bn_ = (IT) & 127, b_ = bn_ >> 5, n_ = bn_ & 31, c0_ = ((IT) >> 7) * 64; \
        _Pragma("unroll") for (int k = 0; k < 2; ++k) _Pragma("unroll") for (int q = 0; q < 4; ++q) { const int tt = n_ * 64 + (tid >> 4) + 32 * k + q - 3; \
            xr[k][q] = tt >= 0 ? *(const u32x2*)(P + (size_t)(b_ * SEQ + tt) * INW + 4096 + c0_ + j4) : (u32x2){0u, 0u}; } } while (0)
    if (bid * per < it_end) LRU_LOADX(bid * per);
    for (int it = bid * per; it < it_end; ++it) {
        const int g = it >> 7, bn = it & 127, b = bn >> 5, n = bn & 31, row0 = b * SEQ + n * 64, ch0 = g * 64;
        if (g != gl) { gl = g;
#pragma unroll
            for (int k = 0; k < 2; ++k) { const int c = tid + NT * k, gate = c >> 9, jr = (c >> 3) & 63, ic = (c & 7) * 8;
                *(LAS u32x4*)(WT + (gate * 64 + jr) * XBS + ic) = *(const u32x4*)(WAT + ((size_t)(g * 2 + gate) * 64 + jr) * 64 + ic); } }
        {
            f32x4 cw[4];
#pragma unroll
            for (int q = 0; q < 4; ++q) cw[q] = *(const f32x4*)(conv_w + q * LW + ch0 + j4);
            const f32x4 cb = *(const f32x4*)(conv_b + ch0 + j4);
#pragma unroll
            for (int k = 0; k < 2; ++k) { const int t = (tid >> 4) + 32 * k; f32x4 v = cb;
#pragma unroll
                for (int q = 0; q < 4; ++q) { const u32x2 r = xr[k][q];
                    v[0] += cw[q][0] * __uint_as_float(r.x << 16); v[1] += cw[q][1] * __uint_as_float(r.x & 0xffff0000u); v[2] += cw[q][2] * __uint_as_float(r.y << 16); v[3] += cw[q][3] * __uint_as_float(r.y & 0xffff0000u); }
                XF[t * 65 + j4] = v[0]; XF[t * 65 + j4 + 1] = v[1]; XF[t * 65 + j4 + 2] = v[2]; XF[t * 65 + j4 + 3] = v[3];
                u32x2 w; w.x = pk2(v[0], v[1]); w.y = pk2(v[2], v[3]); *(LAS u32x2*)(XB + t * XBS + j4) = w; }
        }
        if (it + 1 < it_end) LRU_LOADX(it + 1);
        __syncthreads();
        {
            const int tb = wave & 3, jp = wave >> 2; f32x4 acc[2][2];
#pragma unroll
            for (int ga = 0; ga < 2; ++ga)
#pragma unroll
                for (int jj = 0; jj < 2; ++jj) acc[ga][jj] = (f32x4){0.f, 0.f, 0.f, 0.f};
#pragma unroll
            for (int ks = 0; ks < 2; ++ks) { const bf16x8_t af = *(const LAS bf16x8_t*)(XB + (16 * tb + fr) * XBS + ks * 32 + 8 * fq);
#pragma unroll
                for (int ga = 0; ga < 2; ++ga)
#pragma unroll
                    for (int jj = 0; jj < 2; ++jj) { const bf16x8_t bfr = *(const LAS bf16x8_t*)(WT + (ga * 64 + 16 * (2 * jp + jj) + fr) * XBS + ks * 32 + 8 * fq);
                        acc[ga][jj] = __builtin_amdgcn_mfma_f32_16x16x32_bf16(af, bfr, acc[ga][jj], 0, 0, 0); } }
#pragma unroll
            for (int jj = 0; jj < 2; ++jj) { const int j = 16 * (2 * jp + jj) + fr;
                if (g != gc) { spv[jj] = -8.0f * log1pf(__expf(-lam[ch0 + j])); bav[jj] = ba[ch0 + j]; bxv[jj] = bx[ch0 + j]; }
#pragma unroll
                for (int r = 0; r < 4; ++r) { const int t = 16 * tb + 4 * fq + r;
                    const float rg = __builtin_amdgcn_rcpf(1.0f + __expf(-(acc[0][jj][r] + bav[jj]))), ig = __builtin_amdgcn_rcpf(1.0f + __expf(-(acc[1][jj][r] + bxv[jj])));
                    const float av = __expf(rg * spv[jj]);
                    As[t * 65 + j] = av; Bs[t * 65 + j] = sqrtf(fmaxf(1.0f - av * av, 0.f)) * (ig * XF[t * 65 + j]); } }
            gc = g;
        }
        __syncthreads();
        {
            const int sg = wave, j = lane; float av[8], bv[8];
#pragma unroll
            for (int k = 0; k < 8; ++k) { av[k] = As[(8 * sg + k) * 65 + j]; bv[k] = Bs[(8 * sg + k) * 65 + j]; }
            float pp = 1.f, hh = 0.f;
#pragma unroll
            for (int k = 0; k < 8; ++k) { hh = av[k] * hh + bv[k]; pp *= av[k]; }
            segP[sg * 64 + j] = pp; segH[sg * 64 + j] = hh;
            __syncthreads();
            float hc = 0.f, pc = 1.f;
#pragma unroll
            for (int q = 0; q < 7; ++q) { const float p2 = segP[q * 64 + j], h2 = segH[q * 64 + j]; if (q < sg) { hc = p2 * hc + h2; pc *= p2; } }
#pragma unroll
            for (int k = 0; k < 8; ++k) { hc = av[k] * hc + bv[k]; pc *= av[k]; const size_t o = (size_t)(row0 + 8 * sg + k) * LW + ch0 + j; HL[o] = (bf16_t)f2bf(hc); ACUM[o] = (bf16_t)f2bf(pc); }
            if (sg == 7) { APROD[(b * 32 + n) * LW + ch0 + j] = pc; HEND[(b * 32 + n) * LW + ch0 + j] = hc; }
        }
    }
    __syncthreads();
#undef LRU_LOADX
}
__device__ __forceinline__ void lru_carry_scan(const Args& a, int gtid) {
    const float* APROD = (const float*)(a.ws + WS_APROD); const float* HEND = (const float*)(a.ws + WS_HEND); float* CARRY = (float*)(a.ws + WS_CARRY);
    if (gtid < 4 * LW) { const int b = gtid >> 10, ch = gtid & 1023; float c = 0.f;
        float av[32], hv[32];
#pragma unroll
        for (int n = 0; n < 32; ++n) { const int o = (b * 32 + n) * LW + ch; av[n] = APROD[o]; hv[n] = HEND[o]; }
#pragma unroll
        for (int n = 0; n < 32; ++n) { CARRY[(b * 32 + n) * LW + ch] = c; c = av[n] * c + hv[n]; } }
}
__device__ __forceinline__ void lru_stage3(const Args& a, int l, int gw, int NGW, int lane) {
    const bf16_t* P = (const bf16_t*)(a.ws + WS_P); bf16_t* MIX = (bf16_t*)(a.ws + WS_MIX);
    const bf16_t* HL = (const bf16_t*)(a.ws + WS_HL); const bf16_t* ACUM = (const bf16_t*)(a.ws + WS_ACUM); const float* CARRY = (const float*)(a.ws + WS_CARRY);
    const float* norm_g = a.in[11] + l * LW;
    for (int tb = gw; tb < MTOK; tb += 4 * NGW) {
        f32x4 y[4][4]; float ss[4];
#pragma unroll
        for (int u = 0; u < 4; ++u) { const int t = (tb + u * NGW < MTOK) ? tb + u * NGW : tb, b = t >> 11, n = (t >> 6) & 31; ss[u] = 0.f;
#pragma unroll
            for (int k = 0; k < 4; ++k) { const int ch = k * 256 + lane * 4;
                const u32x2 hr = *(const u32x2*)(HL + (size_t)t * LW + ch), ar = *(const u32x2*)(ACUM + (size_t)t * LW + ch); const f32x4 cr = *(const f32x4*)(CARRY + (b * 32 + n) * LW + ch);
                const f32x4 hl = (f32x4){bflo(hr.x), bfhi(hr.x), bflo(hr.y), bfhi(hr.y)}, ac = (f32x4){bflo(ar.x), bfhi(ar.x), bflo(ar.y), bfhi(ar.y)};
                const u32x2 yr = *(const u32x2*)(P + (size_t)t * INW + 5120 + ch);
                const f32x4 hv = hl + ac * cr;
                y[u][k][0] = hv[0] * gelu_tanh_f(bflo(yr.x)); y[u][k][1] = hv[1] * gelu_tanh_f(bfhi(yr.x)); y[u][k][2] = hv[2] * gelu_tanh_f(bflo(yr.y)); y[u][k][3] = hv[3] * gelu_tanh_f(bfhi(yr.y));
                ss[u] += (y[u][k][0] * y[u][k][0] + y[u][k][1] * y[u][k][1]) + (y[u][k][2] * y[u][k][2] + y[u][k][3] * y[u][k][3]); } }
#pragma unroll
        for (int u = 0; u < 4; ++u) { const int t = (tb + u * NGW < MTOK) ? tb + u * NGW : tb; const float rs = 1.0f / sqrtf(wave_sum(ss[u]) * (1.0f / LW) + EPS);
#pragma unroll
            for (int k = 0; k < 4; ++k) { const int ch = k * 256 + lane * 4; const f32x4 gv = *(const f32x4*)(norm_g + ch); const f32x4 z = y[u][k] * rs * gv;
                u32x2 w; w.x = pk2(z[0], z[1]); w.y = pk2(z[2], z[3]); *(u32x2*)(MIX + (size_t)t * DM + 1024 + ch) = w; } } }
}

#define XB_TMO      128
#define XB_XCNT(j)  (256  + 64 * (j))
#define XB_XSUB(j)  (1280 + 64 * (j))
#define XB_XGEN(j)  (2304 + 64 * (j))
#define XB_TOP      3328
#define XB_TOPGEN   3392
#define XCD_BAR_WORDS 3456
#define XB_SPIN_CAP (1u << 18)

__device__ __forceinline__ unsigned xb_ld(unsigned* p)              { return __hip_atomic_load(p, __ATOMIC_RELAXED, __HIP_MEMORY_SCOPE_AGENT); }
__device__ __forceinline__ unsigned xb_add(unsigned* p, unsigned v) { return __hip_atomic_fetch_add(p, v, __ATOMIC_RELAXED, __HIP_MEMORY_SCOPE_AGENT); }
__device__ __forceinline__ unsigned xb_xcc_id() { return (unsigned)__builtin_amdgcn_s_getreg((3 << 11) | 20) & 0xFu; }
#define XB_SPIN(cond, bar) do { unsigned _sp = 0; while (cond) { __builtin_amdgcn_s_sleep(1); \
    if ((++_sp & 255u) == 0u) { if (xb_ld(&(bar)[XB_TMO])) break; if (_sp > XB_SPIN_CAP) { atomicAdd(&(bar)[XB_TMO], 1u); break; } } } } while (0)

struct XcdBarrier {
    unsigned* bar; unsigned x;
    volatile LAS unsigned* st;
};

__device__ __forceinline__ XcdBarrier xcd_barrier_post(unsigned* bar, volatile LAS unsigned* st) {
    XcdBarrier b; b.bar = bar; b.x = xb_xcc_id(); b.st = st;
    if (threadIdx.x == 0) (void)xb_add(&bar[XB_XCNT(b.x)], 1u);
    return b;
}
__device__ __forceinline__ void xcd_barrier_complete(unsigned* bar, unsigned x, unsigned& nloc, unsigned& nx) {
    const unsigned G = gridDim.x * gridDim.y * gridDim.z;
    unsigned sum, cnt, mine, sp = 0u;
    for (;;) {
        sum = 0u; cnt = 0u; mine = 0u;
#pragma unroll
        for (unsigned j = 0; j < 16; ++j) { const unsigned c = xb_ld(&bar[XB_XCNT(j)]); sum += c; cnt += (c > 0u) ? 1u : 0u; mine = (j == x) ? c : mine; }
        if (sum == G) break;
        __builtin_amdgcn_s_sleep(1);
        if ((++sp & 255u) == 0u) { if (xb_ld(&bar[XB_TMO])) break; if (sp > XB_SPIN_CAP) { atomicAdd(&bar[XB_TMO], 1u); break; } }
    }
    nloc = mine > 0u ? mine : 1u; nx = cnt > 0u ? cnt : 1u;
}

__device__ __forceinline__ void xcd_barrier(const XcdBarrier& b) {
    asm volatile("s_waitcnt vmcnt(0)" ::: "memory");
    __syncthreads();
    if (threadIdx.x == 0) {
        unsigned* bar = b.bar;
        __builtin_amdgcn_s_waitcnt(0);
        unsigned nloc = b.st[0], nx = b.st[1];
        if (nloc == 0u) { xcd_barrier_complete(bar, b.x, nloc, nx); b.st[0] = nloc; b.st[1] = nx; }
        const unsigned old = xb_add(&bar[XB_XSUB(b.x)], 1u);
        const unsigned gen = old / nloc;
        if (old + 1u == (gen + 1u) * nloc) {
            __builtin_amdgcn_fence(__ATOMIC_RELEASE, "agent");
            asm volatile("s_waitcnt vmcnt(0)" ::: "memory");
            const unsigned og = xb_add(&bar[XB_TOP], 1u);
            const unsigned tg = og / nx;
            if (og + 1u == (tg + 1u) * nx) xb_add(&bar[XB_TOPGEN], 1u);
            else XB_SPIN(xb_ld(&bar[XB_TOPGEN]) == tg, bar);
            __builtin_amdgcn_fence(__ATOMIC_ACQUIRE, "agent");
            xb_add(&bar[XB_XGEN(b.x)], 1u);
            asm volatile("s_waitcnt vmcnt(0)" ::: "memory");
        } else {
            XB_SPIN(xb_ld(&bar[XB_XGEN(b.x)]) == gen, bar);
            __builtin_amdgcn_fence(__ATOMIC_ACQUIRE, "agent");
            asm volatile("s_waitcnt vmcnt(0)" ::: "memory");
        }
    }
    __syncthreads();
}


constexpr int NPHASE = 16;
template <bool COOP>
__global__ void __launch_bounds__(NT, 2) hybrid_fwd(Args a) {
    extern __shared__ __attribute__((aligned(16))) unsigned char lds_raw[];
    LAS unsigned char* lds = (LAS unsigned char*)lds_raw;
    const int bid = blockIdx.x;
    bf16_t* WIN = (bf16_t*)(a.ws + WS_WIN); bf16_t* WOUT = (bf16_t*)(a.ws + WS_WOUT); bf16_t* WGU = (bf16_t*)(a.ws + WS_WGU); bf16_t* WDN = (bf16_t*)(a.ws + WS_WDN);
    bf16_t* PB = (bf16_t*)(a.ws + WS_P); bf16_t* MIX = (bf16_t*)(a.ws + WS_MIX); bf16_t* HB = (bf16_t*)(a.ws + WS_H);
    const unsigned long long pc0 = (unsigned long long)__builtin_amdgcn_s_getpc() & ~0xFFFull;
    const float* x_in = a.in[0]; float* XR = a.out; float* SLOTS = (float*)(a.ws + WS_SLOTS); unsigned* CNT = (unsigned*)(a.ws + WS_CNT);
    XcdBarrier xb; xb.bar = (unsigned*)(a.ws + WS_BAR); xb.x = 0; xb.st = nullptr;
    {
        volatile LAS unsigned* st = (volatile LAS unsigned*)(lds + LDS_BYTES - 16);
        if (threadIdx.x < 4) st[threadIdx.x] = 0u;
        if (a.ph_lo == 0 && bid == 0) {
            for (int i = threadIdx.x; i < XCD_BAR_WORDS; i += NT) ((unsigned*)(a.ws + WS_BAR))[i] = 0u;
            for (int i = threadIdx.x; i < 4 * 512; i += NT) ((unsigned*)(a.ws + WS_CNT))[i] = 0u; }
        __syncthreads();
    }
    for (int ph = a.ph_lo; ph < a.ph_hi; ++ph) {
        const int l = (ph - 1) / 8, sp = (ph == 0) ? -1 : (ph - 1) % 8;
        int tid_ = threadIdx.x; asm volatile("" : "+v"(tid_));
        int G_ = gridDim.x; asm volatile("" : "+s"(G_)); const int G = G_, NGW = G * 8, NG = G * NT;
        const int tid = tid_, lane = tid & 63, wave = __builtin_amdgcn_readfirstlane(tid >> 6), gw = bid * 8 + wave, gtid = bid * NT + tid;
        if (wave < 4) __builtin_amdgcn_global_load_lds((const unsigned*)(pc0 + (unsigned long long)(((bid >> 3) & 31) * 4096 + wave * 1024 + lane * 16)), (LAS unsigned*)(lds + 134144), 16, 0, 0);
        if (ph == 0) {
            convert_weights(a, 0, lds, wave * G + bid, NGW, wave, lane, 0);
            rope_table((float2*)(a.ws + WS_ROPE), gtid, NG);
            lru_gate_weights(a, gtid, NG);
            rmsnorm_rows<false>(x_in, a.in[1], HB, gw, NGW, lane);
        } else if (sp == 0) {
            pg8::Gemm g{HB, WIN, MTOK, INW, DM}; pg8::StaticOrder S; S.init(MTOK, INW, G, bid); pg8::EpiBf16 E{PB, INW};
            pg8::gemm_phase<pg8::EpiBf16, pg8::StaticOrder, true, true>(lds, g, S, E);
        } else if (sp == 1) {
            ret_stage1_block(a, lds, bid, G, tid);
            lru_stage1_block(a, l, lds, bid, G, tid);
        } else if (sp == 2) {
            lru_carry_scan(a, gtid);
            ret_scan(a, gtid, NG);
        } else if (sp == 3) {
            ret_stage3_block(a, l, lds, bid, G, tid);
            lru_stage3(a, l, gw, NGW, lane);
        } else if (sp == 4) {
            pg8::Gemm g{MIX, WOUT, MTOK, DM, DM}; pg8::StaticOrder S; S.init(MTOK, DM, G, bid);
            pg8::EpiResNorm<false> E{l == 0 ? x_in : XR, XR, HB, a.in[13] + l * DM, SLOTS + (size_t)(2 * l) * MTOK * 8, CNT + (2 * l) * 512};
            pg8::gemm_phase<pg8::EpiResNorm<false>, pg8::StaticOrder, true, true>(lds, g, S, E);
        } else if (sp == 5) {
            pg8::Gemm g{HB, WGU, MTOK, 2 * DFF, DM}; pg8::StaticOrder S; S.init(MTOK, 2 * DFF, G, bid); pg8::EpiSwiglu E{PB, DFF};
            pg8::gemm_phase<pg8::EpiSwiglu, pg8::StaticOrder, true, true>(lds, g, S, E);
            if (l == 0) { const int nt_all = (MTOK / 256) * (2 * DFF / 256), rem = nt_all % G;
                if (rem != 0 && bid >= rem) { __syncthreads(); convert_weights(a, 1, lds, wave * (G - rem) + (bid - rem), (G - rem) * 8, wave, lane, 1); }
                else if (rem == 0) { __syncthreads(); convert_weights(a, 1, lds, gw, NGW, wave, lane, 1); } }
        } else if (sp == 6) {
            pg8::Gemm g{PB, WDN, MTOK, DM, DFF}; pg8::StaticOrder S; S.init(MTOK, DM, G, bid);
            if (l == 0) { pg8::EpiResNorm<false> E{XR, XR, HB, a.in[1] + DM, SLOTS + (size_t)MTOK * 8, CNT + 512}; pg8::gemm_phase<pg8::EpiResNorm<false>, pg8::StaticOrder, true, true>(lds, g, S, E); }
            else { pg8::EpiResNorm<true> E{XR, XR, HB, a.in[17], SLOTS + (size_t)3 * MTOK * 8, CNT + 3 * 512}; pg8::gemm_phase<pg8::EpiResNorm<true>, pg8::StaticOrder, true, true>(lds, g, S, E); }
        } else {
            convert_weights(a, 1, lds, wave * G + bid, NGW, wave, lane, 2);
        }
        if (COOP) { if (ph + 1 < a.ph_hi) { if (ph == 0) { cg::this_grid().sync(); xb = xcd_barrier_post((unsigned*)(a.ws + WS_BAR), (volatile LAS unsigned*)(lds + LDS_BYTES - 16)); } else xcd_barrier(xb); } }
        else __syncthreads();
    }
}

extern "C" void kernel_launch(void* const* d_in, const int* in_sizes, int n_in, void* d_out, int out_size, void* d_ws, size_t ws_size, hipStream_t stream) {
    static int grid = 0;
    if (grid == 0) {
        if (n_in != 18 || out_size != MTOK * DM || ws_size < WS_END) { fprintf(stderr, "kernel_launch: unexpected shapes (n_in %d out %d ws %zu)\n", n_in, out_size, ws_size); grid = -1; return; }
        int dev = 0, cus = 0, per_cu = 0;
        hipGetDevice(&dev); hipDeviceGetAttribute(&cus, hipDeviceAttributeMultiprocessorCount, dev);
        hipFuncSetAttribute((const void*)hybrid_fwd<true>, hipFuncAttributeMaxDynamicSharedMemorySize, LDS_BYTES);
        hipFuncSetAttribute((const void*)hybrid_fwd<false>, hipFuncAttributeMaxDynamicSharedMemorySize, LDS_BYTES);
        hipOccupancyMaxActiveBlocksPerMultiprocessor(&per_cu, (const void*)hybrid_fwd<true>, NT, LDS_BYTES);
        if (per_cu < 1) { fprintf(stderr, "kernel_launch: occupancy query says %d blocks per CU\n", per_cu); per_cu = 1; }
        (void)hipGetLastError();
        grid = cus * 1;
    }
    if (grid < 0) return;
    Args a{};
    for (int i = 0; i < 18; ++i) a.in[i] = (const float*)d_in[i];
    a.out = (float*)d_out; a.ws = (unsigned char*)d_ws;
#if MEGA
    a.ph_lo = 0; a.ph_hi = NPHASE;
    void* args[] = {&a};
    hipError_t e = hipLaunchCooperativeKernel((const void*)hybrid_fwd<true>, dim3(grid), dim3(NT), args, LDS_BYTES, stream);
    if (e != hipSuccess) fprintf(stderr, "cooperative launch failed: %s (grid %d)\n", hipGetErrorString(e), grid);
#else
    for (int ph = 0; ph < NPHASE; ++ph) { a.ph_lo = ph; a.ph_hi = ph + 1; hipLaunchKernelGGL(hybrid_fwd<false>, dim3(grid), dim3(NT), LDS_BYTES, stream, a); }
#endif
}
```

```cpp
#include <hip/hip_runtime.h>
#include <hip/hip_cooperative_groups.h>
#include <cstdio>
#include <cstdint>
namespace cg = cooperative_groups;

#ifndef MEGA
#define MEGA 1
#endif

namespace pg8 {
#define PG8_LAS __attribute__((address_space(3)))
typedef unsigned short bf16_t;
typedef short bf16x8 __attribute__((ext_vector_type(8)));
typedef float f32x4 __attribute__((ext_vector_type(4)));
typedef unsigned u32x4 __attribute__((ext_vector_type(4)));
typedef unsigned u32x2 __attribute__((ext_vector_type(2)));
constexpr int BM = 256, BK = 64, HALF = 128, HTB = HALF * BK * 2  , STAGE_BYTES = 8 * HTB, NXCD = 8, WGM = 8;

__host__ __device__ __forceinline__ int lds_byte(int r, int c) { const int st = (r >> 4) * 2 + (c >> 5), rr = r & 15, cc = c & 31, ob = rr * 64 + cc * 2; return st * 1024 + (ob ^ (((ob >> 9) & 1) << 5)); }
__host__ __device__ __forceinline__ void stage_rc(int b, int& R, int& C) { const int st = b / 1024, sb = b % 1024, swz = sb ^ (((sb >> 9) & 1) << 5); R = (st >> 1) * 16 + swz / 64; C = (st & 1) * 32 + (swz % 64) / 2; }
__host__ __device__ __forceinline__ int perm32(int rho) { const int n = rho >> 4, i = rho & 15; return 8 * (i >> 2) + 4 * n + (i & 3); }

struct Unit { int pm, pn; };
struct Gemm { const bf16_t* A; const bf16_t* Bt; int M, N, K; };

struct StaticOrder {
    int nM, nN, nwg, G, c;
    __host__ __device__ void init(int M, int N, int G_, int c_) { nM = M / BM; nN = N / BM; nwg = nM * nN; G = G_; c = c_; }
    __host__ __device__ bool next(int i, Unit& u) const {
        const long L = (long)i * G + c; if (L >= nwg) return false;
        int wgid = (int)L; { const int q = nwg / NXCD, r = nwg % NXCD, xcd = wgid % NXCD, off = wgid / NXCD; wgid = (xcd < r ? xcd * (q + 1) : r * (q + 1) + (xcd - r) * q) + off; }
        const int nig = WGM * nN, gid = wgid / nig, fm = gid * WGM, gsz = (nM - fm) < WGM ? (nM - fm) : WGM;
        u.pm = fm + ((wgid % nig) % gsz); u.pn = (wgid % nig) / gsz; return true;
    }
    __device__ __forceinline__ void a_ready(const Unit&) const {}
    __device__ __forceinline__ void done(const Unit&) const {}
};

typedef __bf16 bf16x2_cv __attribute__((ext_vector_type(2)));
typedef float f32x2_cv __attribute__((ext_vector_type(2)));
__device__ __forceinline__ unsigned cvt_pk_bf16(float lo, float hi) { const f32x2_cv v = {lo, hi}; return __builtin_bit_cast(unsigned, __builtin_convertvector(v, bf16x2_cv)); }
__device__ __forceinline__ float silu_f(float g) { return g * __builtin_amdgcn_rcpf(1.0f + __expf(-g)); }

struct EpiBf16 {
    static constexpr bool PERM = true, AFTER_DRAIN = false;
    bf16_t* O; int ldc;
    __device__ __forceinline__ void operator()(const f32x4 (&acc)[2][2][4][2], const Unit& u, int wr, int wc, int fr, int fq) const {
        const int row0 = u.pm * BM + wr * 64 + fr, col0 = u.pn * BM + wc * 32 + 8 * fq;
#pragma unroll
        for (int ai = 0; ai < 2; ++ai)
#pragma unroll
            for (int m = 0; m < 4; ++m) { bf16_t* rowp = O + (size_t)(row0 + ai * HALF + m * 16) * ldc + col0;
#pragma unroll
                for (int bj = 0; bj < 2; ++bj) { const f32x4 v0 = acc[ai][bj][m][0], v1 = acc[ai][bj][m][1];
                    u32x4 w; w.x = cvt_pk_bf16(v0[0], v0[1]); w.y = cvt_pk_bf16(v0[2], v0[3]); w.z = cvt_pk_bf16(v1[0], v1[1]); w.w = cvt_pk_bf16(v1[2], v1[3]);
                    *(u32x4*)(rowp + bj * HALF) = w; } }
    }
};
struct EpiSwiglu {
    static constexpr bool PERM = true, AFTER_DRAIN = false;
    bf16_t* O; int ldc;
    __device__ __forceinline__ void operator()(const f32x4 (&acc)[2][2][4][2], const Unit& u, int wr, int wc, int fr, int fq) const {
        const int row0 = u.pm * BM + wr * 64 + fr, col0 = u.pn * HALF + wc * 32 + 8 * fq;
#pragma unroll
        for (int ai = 0; ai < 2; ++ai)
#pragma unroll
            for (int m = 0; m < 4; ++m) { bf16_t* rowp = O + (size_t)(row0 + ai * HALF + m * 16) * ldc + col0;
                const f32x4 g0 = acc[ai][0][m][0], g1 = acc[ai][0][m][1], u0 = acc[ai][1][m][0], u1 = acc[ai][1][m][1];
                u32x4 w; w.x = cvt_pk_bf16(silu_f(g0[0]) * u0[0], silu_f(g0[1]) * u0[1]); w.y = cvt_pk_bf16(silu_f(g0[2]) * u0[2], silu_f(g0[3]) * u0[3]);
                w.z = cvt_pk_bf16(silu_f(g1[0]) * u1[0], silu_f(g1[1]) * u1[1]); w.w = cvt_pk_bf16(silu_f(g1[2]) * u1[2], silu_f(g1[3]) * u1[3]);
                *(u32x4*)rowp = w; }
    }
};

template <bool FINAL> struct EpiResNorm {
    static constexpr bool PERM = false, AFTER_DRAIN = true;
    const float* R; float* C; bf16_t* HB; const float* gain; float* slots; unsigned* cnt;
    __device__ __forceinline__ void fused(f32x4 (&acc)[2][2][4][2], const Unit& u, int wr, int wc, int fr, int fq, PG8_LAS unsigned char* lds, int wid, int lane) const {
        PG8_LAS float* Pt = (PG8_LAS float*)lds;
        PG8_LAS float* Rs = Pt + 1024;
        const int row0 = u.pm * BM + wr * 64 + fr, col0 = u.pn * BM + wc * 32 + 4 * fq, ldc = 2048;
#pragma unroll
        for (int ai = 0; ai < 2; ++ai)
#pragma unroll
            for (int m = 0; m < 4; ++m) { const size_t off = (size_t)(row0 + ai * HALF + m * 16) * ldc + col0; float ss = 0.f;
#pragma unroll
                for (int bj = 0; bj < 2; ++bj)
#pragma unroll
                    for (int n = 0; n < 2; ++n) { const f32x4 r = *(const f32x4*)(R + off + bj * HALF + n * 16); const f32x4 v = r + acc[ai][bj][m][n]; acc[ai][bj][m][n] = v;
                        ss += (v[0] * v[0] + v[1] * v[1]) + (v[2] * v[2] + v[3] * v[3]); }
                ss += __shfl_xor(ss, 16); ss += __shfl_xor(ss, 32);
                if (fq == 0) Pt[(ai * HALF + wr * 64 + m * 16 + fr) * 4 + wc] = ss; }
        __syncthreads();
        const int tid = wid * 64 + lane;
        if (wid < 4) {
            const f32x4 p4 = *(const PG8_LAS f32x4*)(Pt + tid * 4);
            __hip_atomic_store(slots + (size_t)(u.pm * BM + tid) * 8 + u.pn, (p4[0] + p4[1]) + (p4[2] + p4[3]), __ATOMIC_RELAXED, __HIP_MEMORY_SCOPE_AGENT);
            asm volatile("s_waitcnt vmcnt(0)" ::: "memory");
            if (lane == 0) (void)__hip_atomic_fetch_add(cnt + 16 * u.pm, 1u, __ATOMIC_RELAXED, __HIP_MEMORY_SCOPE_AGENT);
        }
        if (wid == 0) {
            unsigned spins = 0;
            while ((unsigned)__builtin_amdgcn_readfirstlane(__hip_atomic_load(cnt + 16 * u.pm, __ATOMIC_RELAXED, __HIP_MEMORY_SCOPE_AGENT)) < 32u) { __builtin_amdgcn_s_sleep(2); if (++spins > (1u << 18)) break; }
            __builtin_amdgcn_fence(__ATOMIC_ACQUIRE, "agent");
            asm volatile("s_waitcnt vmcnt(0)" ::: "memory");
        }
        __syncthreads();
        if (wid < 4) { float t = 0.f;
#pragma unroll
            for (int k = 0; k < 8; ++k) t += __hip_atomic_load(slots + (size_t)(u.pm * BM + tid) * 8 + k, __ATOMIC_RELAXED, __HIP_MEMORY_SCOPE_AGENT);
            Rs[tid] = 1.0f / sqrtf(t * (1.0f / 2048.0f) + 1e-6f); }
        __syncthreads();
        f32x4 gv[2][2];
#pragma unroll
        for (int bj = 0; bj < 2; ++bj)
#pragma unroll
            for (int n = 0; n < 2; ++n) gv[bj][n] = *(const f32x4*)(gain + col0 + bj * HALF + n * 16);
#pragma unroll
        for (int ai = 0; ai < 2; ++ai)
#pragma unroll
            for (int m = 0; m < 4; ++m) { const size_t off = (size_t)(row0 + ai * HALF + m * 16) * ldc + col0; const float rs = Rs[ai * HALF + wr * 64 + m * 16 + fr];
#pragma unroll
                for (int bj = 0; bj < 2; ++bj)
#pragma unroll
                    for (int n = 0; n < 2; ++n) { const f32x4 v = acc[ai][bj][m][n], y = v * rs * gv[bj][n];
                        if (FINAL) { *(f32x4*)(C + off + bj * HALF + n * 16) = y; }
                        else { *(f32x4*)(C + off + bj * HALF + n * 16) = v; u32x2 w; w.x = cvt_pk_bf16(y[0], y[1]); w.y = cvt_pk_bf16(y[2], y[3]); *(u32x2*)(HB + off + bj * HALF + n * 16) = w; } } }
    }
};

template <class Epi, class Sched, bool ALIGN_EPI = false, bool SP2 = false>
__device__ __forceinline__ void gemm_phase(PG8_LAS unsigned char* lds, const Gemm g, const Sched& S, const Epi& E) {
    int tid_ = threadIdx.x; asm volatile("" : "+v"(tid_));
    const int tid = tid_, wid = __builtin_amdgcn_readfirstlane(tid >> 6), lane = tid & 63, wr = wid >> 2, wc = wid & 3, fr = lane & 15, fq = lane >> 4;
    const int K = g.K, nt = K / BK;
    unsigned voffA[2], voffB[2];
#pragma unroll
    for (int i = 0; i < 2; ++i) { int R, C; stage_rc(tid * 16 + i * 8192, R, C); const int Rb = Epi::PERM ? ((R & ~31) + perm32(R & 31)) : R;
        voffA[i] = (unsigned)(R * K + C) * 2u; voffB[i] = (unsigned)(Rb * K + C) * 2u; }
    const size_t kstep = (size_t)(BK * 2);
    const size_t hstep = (size_t)HALF * K * 2;
    const size_t tstep = 2 * hstep;
    const unsigned ldsw = (unsigned)wid * 1024u;
    const int aoff = lds_byte(wr * 64 + fr, fq * 8), boff = lds_byte(wc * 32 + fr, fq * 8);
#define PG8_SA(b, h) (((b) * 2 + (h)) * HTB)
#define PG8_SB(b, h) ((4 + (b) * 2 + (h)) * HTB)
#define PG8_STAGE(bufoff, gbase, voff) do { _Pragma("unroll") for (int _i = 0; _i < 2; ++_i) \
        __builtin_amdgcn_global_load_lds((const unsigned*)((const char*)(gbase) + (voff)[_i]), (PG8_LAS unsigned*)(lds + (bufoff) + ldsw + _i * 8192), 16, 0, 0); } while (0)
#define PG8_LDA(dst, b, h) do { _Pragma("unroll") for (int m = 0; m < 4; ++m) _Pragma("unroll") for (int k = 0; k < 2; ++k) dst[m][k] = *(const PG8_LAS bf16x8*)(lds + PG8_SA(b, h) + aoff + m * 2048 + k * 1024); } while (0)
#define PG8_LDB(dst, b, h) do { _Pragma("unroll") for (int n = 0; n < 2; ++n) _Pragma("unroll") for (int k = 0; k < 2; ++k) dst[n][k] = *(const PG8_LAS bf16x8*)(lds + PG8_SB(b, h) + boff + n * 2048 + k * 1024); } while (0)
#define PG8_MMA(ai, bj, At, Bt) do { __builtin_amdgcn_s_setprio(1); _Pragma("unroll") for (int m = 0; m < 4; ++m) _Pragma("unroll") for (int n = 0; n < 2; ++n) _Pragma("unroll") for (int k = 0; k < 2; ++k) \
        acc[ai][bj][m][n] = __builtin_amdgcn_mfma_f32_16x16x32_bf16(Bt[n][k], At[m][k], acc[ai][bj][m][n], 0, 0, 0); __builtin_amdgcn_s_setprio(0); } while (0)
#define PG8_WAIT_V(n) asm volatile("s_waitcnt vmcnt(" #n ")" ::: "memory")
#define PG8_WAIT_L(n) asm volatile("s_waitcnt lgkmcnt(" #n ")" ::: "memory")
#define PG8_BAR __builtin_amdgcn_s_barrier()
#define PG8_SCHED __builtin_amdgcn_sched_barrier(0)
    Unit cur, nxt; int ui = 0;
    if (!S.next(0, cur)) return;
    f32x4 acc[2][2][4][2];
#pragma unroll
    for (int a = 0; a < 2; ++a)
#pragma unroll
        for (int b = 0; b < 2; ++b)
#pragma unroll
            for (int m = 0; m < 4; ++m)
#pragma unroll
                for (int n = 0; n < 2; ++n) acc[a][b][m][n] = (f32x4){0.f, 0.f, 0.f, 0.f};
    bf16x8 At[4][2], B0[2][2], B1[2][2];
    const char* cA = (const char*)g.A + (size_t)cur.pm * tstep; const char* cB = (const char*)g.Bt + (size_t)cur.pn * tstep;
    S.a_ready(cur);
    if constexpr (SP2) {
        PG8_STAGE(PG8_SB(0, 0), cB, voffB); PG8_STAGE(PG8_SB(0, 1), cB + hstep, voffB); PG8_STAGE(PG8_SA(0, 0), cA, voffA); PG8_STAGE(PG8_SA(0, 1), cA + hstep, voffA);
        if (wr == 1) PG8_BAR;
        PG8_WAIT_V(2); PG8_BAR;
        PG8_STAGE(PG8_SB(1, 0), cB + kstep, voffB); PG8_STAGE(PG8_SA(1, 0), cA + kstep, voffA); PG8_STAGE(PG8_SB(1, 1), cB + hstep + kstep, voffB);
        PG8_WAIT_V(6); PG8_BAR;
    } else {
        PG8_STAGE(PG8_SB(0, 0), cB, voffB); PG8_STAGE(PG8_SA(0, 0), cA, voffA); PG8_STAGE(PG8_SB(0, 1), cB + hstep, voffB); PG8_STAGE(PG8_SA(0, 1), cA + hstep, voffA);
        if (wr == 1) PG8_BAR;
        PG8_WAIT_V(4); PG8_BAR;
        PG8_STAGE(PG8_SB(1, 0), cB + kstep, voffB); PG8_STAGE(PG8_SA(1, 0), cA + kstep, voffA); PG8_STAGE(PG8_SB(1, 1), cB + hstep + kstep, voffB);
        PG8_WAIT_V(6); PG8_BAR;
    }
    for (;;) {
        const bool has_next = S.next(ui + 1, nxt);
        const char* nA = has_next ? (const char*)g.A + (size_t)nxt.pm * tstep : cA; const char* nB = has_next ? (const char*)g.Bt + (size_t)nxt.pn * tstep : cB;
        for (int t = 0; t < nt; t += 2) {
            const bool last = (t == nt - 2);
            const char* a1 = cA + (size_t)(t + 1) * kstep;
            const char* a2 = last ? nA : cA + (size_t)(t + 2) * kstep; const char* b2 = last ? nB : cB + (size_t)(t + 2) * kstep;
            const char* a3 = a2 + kstep; const char* b3 = b2 + kstep;
            if (last && has_next) S.a_ready(nxt);
            if constexpr (SP2) {
            PG8_LDB(B0, 0, 0); PG8_LDB(B1, 0, 1); PG8_SCHED; PG8_LDA(At, 0, 0); PG8_STAGE(PG8_SA(1, 1), a1 + hstep, voffA);
            PG8_WAIT_V(8); PG8_WAIT_L(0); PG8_BAR; PG8_MMA(0, 0, At, B0); PG8_MMA(0, 1, At, B1); PG8_BAR; PG8_SCHED;
            PG8_LDA(At, 0, 1); PG8_STAGE(PG8_SB(0, 0), b2, voffB); PG8_STAGE(PG8_SB(0, 1), b2 + hstep, voffB); PG8_STAGE(PG8_SA(0, 0), a2, voffA);
            PG8_WAIT_V(8); PG8_WAIT_L(0); PG8_BAR; PG8_MMA(1, 0, At, B0); PG8_MMA(1, 1, At, B1); PG8_BAR; PG8_SCHED;
            PG8_LDB(B0, 1, 0); PG8_LDB(B1, 1, 1); PG8_SCHED; PG8_LDA(At, 1, 0); PG8_STAGE(PG8_SA(0, 1), a2 + hstep, voffA);
            PG8_WAIT_V(8); PG8_WAIT_L(0); PG8_BAR; PG8_MMA(0, 0, At, B0); PG8_MMA(0, 1, At, B1); PG8_BAR; PG8_SCHED;
            PG8_LDA(At, 1, 1); PG8_STAGE(PG8_SB(1, 0), b3, voffB); PG8_STAGE(PG8_SB(1, 1), b3 + hstep, voffB); PG8_STAGE(PG8_SA(1, 0), a3, voffA);
            PG8_WAIT_V(8); PG8_WAIT_L(0); PG8_BAR; PG8_MMA(1, 0, At, B0); PG8_MMA(1, 1, At, B1); PG8_BAR; PG8_SCHED;
            } else {
            PG8_LDB(B0, 0, 0); PG8_SCHED; PG8_LDA(At, 0, 0); PG8_STAGE(PG8_SA(1, 1), a1 + hstep, voffA);
            PG8_WAIT_L(8); PG8_BAR; PG8_WAIT_L(0); PG8_MMA(0, 0, At, B0); PG8_BAR; PG8_SCHED;
            PG8_LDB(B1, 0, 1); PG8_STAGE(PG8_SB(0, 0), b2, voffB);
            PG8_BAR; PG8_WAIT_L(0); PG8_MMA(0, 1, At, B1); PG8_BAR;
            PG8_LDA(At, 0, 1); PG8_STAGE(PG8_SA(0, 0), a2, voffA);
            PG8_BAR; PG8_WAIT_L(0); PG8_MMA(1, 0, At, B0); PG8_BAR; PG8_SCHED;
            PG8_STAGE(PG8_SB(0, 1), b2 + hstep, voffB);
            PG8_WAIT_V(6); PG8_BAR; PG8_MMA(1, 1, At, B1); PG8_BAR;
            PG8_LDB(B0, 1, 0); PG8_SCHED; PG8_LDA(At, 1, 0); PG8_STAGE(PG8_SA(0, 1), a2 + hstep, voffA);
            PG8_WAIT_L(8); PG8_BAR; PG8_WAIT_L(0); PG8_MMA(0, 0, At, B0); PG8_BAR; PG8_SCHED;
            PG8_LDB(B1, 1, 1); PG8_STAGE(PG8_SB(1, 0), b3, voffB);
            PG8_BAR; PG8_WAIT_L(0); PG8_MMA(0, 1, At, B1); PG8_BAR;
            PG8_LDA(At, 1, 1); PG8_STAGE(PG8_SA(1, 0), a3, voffA);
            PG8_BAR; PG8_WAIT_L(0); PG8_MMA(1, 0, At, B0); PG8_BAR; PG8_SCHED;
            PG8_STAGE(PG8_SB(1, 1), b3 + hstep, voffB);
            PG8_WAIT_V(6); PG8_BAR; PG8_MMA(1, 1, At, B1); PG8_BAR;
            }
        }
        if constexpr (ALIGN_EPI) { if (wr == 0) PG8_BAR; }
        if constexpr (!Epi::AFTER_DRAIN) { E(acc, cur, wr, wc, fr, fq); S.done(cur); }
        if (!has_next) break;
#pragma unroll
        for (int a = 0; a < 2; ++a)
#pragma unroll
            for (int b = 0; b < 2; ++b)
#pragma unroll
                for (int m = 0; m < 4; ++m)
#pragma unroll
                    for (int n = 0; n < 2; ++n) acc[a][b][m][n] = (f32x4){0.f, 0.f, 0.f, 0.f};
        cur = nxt; cA = nA; cB = nB; ++ui;
        if constexpr (ALIGN_EPI) { if (wr == 1) PG8_BAR; }
    }
    PG8_WAIT_V(0);
    if constexpr (!ALIGN_EPI) { if (wr == 0) PG8_BAR; }
    PG8_BAR;
    if constexpr (Epi::AFTER_DRAIN) { E.fused(acc, cur, wr, wc, fr, fq, lds, wid, lane); S.done(cur); }
#undef PG8_SA
#undef PG8_SB
#undef PG8_STAGE
#undef PG8_LDA
#undef PG8_LDB
#undef PG8_MMA
#undef PG8_WAIT_V
#undef PG8_WAIT_L
#undef PG8_BAR
#undef PG8_SCHED
}
}

#define LAS __attribute__((address_space(3)))
typedef unsigned short bf16_t;
typedef float f32x4 __attribute__((ext_vector_type(4)));
typedef unsigned u32x4 __attribute__((ext_vector_type(4)));
typedef unsigned u32x2 __attribute__((ext_vector_type(2)));
constexpr int DM = 2048, SEQ = 2048, MTOK = 8192, DEPTH = 2;
constexpr int RH = 8, RW = 1024, LW = 1024, INW = 6144, DFF = 5632, NCH = 32;
constexpr float EPS = 1e-6f;
constexpr int NT = 512;
constexpr int LDS_BYTES = 136 * 1024;

constexpr size_t MiB = 1u << 20;
constexpr size_t WS_ROPE = 0;
constexpr size_t WS_WIN = 1 * MiB;
constexpr size_t WS_WOUT = 25 * MiB;
constexpr size_t WS_WGU = 33 * MiB;
constexpr size_t WS_WDN = 77 * MiB;
constexpr size_t WS_P = 99 * MiB;
constexpr size_t WS_U = 195 * MiB;
constexpr size_t WS_MIX = 259 * MiB;
constexpr size_t WS_H = 291 * MiB;
constexpr size_t WS_HL = 323 * MiB;
constexpr size_t WS_ACUM = 355 * MiB;
constexpr size_t WS_APROD = 387 * MiB;
constexpr size_t WS_HEND = 387 * MiB + 512 * 1024;
constexpr size_t WS_BAR = 388 * MiB;
constexpr size_t WS_CARRY = 389 * MiB;
constexpr size_t WS_WAT = 389 * MiB + 512 * 1024;
constexpr size_t WS_SB = 390 * MiB;
constexpr size_t WS_SLOTS = 422 * MiB;
constexpr size_t WS_CNT = 423 * MiB;
constexpr size_t WS_END = 424 * MiB;

__device__ __forceinline__ float bf2f(bf16_t v) { return __uint_as_float((unsigned)v << 16); }
typedef __bf16 bf16x2_hw __attribute__((ext_vector_type(2)));
typedef float f32x2_hw __attribute__((ext_vector_type(2)));
__device__ __forceinline__ unsigned pk2(float lo, float hi) { const f32x2_hw v = {lo, hi}; return __builtin_bit_cast(unsigned, __builtin_convertvector(v, bf16x2_hw)); }
__device__ __forceinline__ unsigned f2bf(float f) { return pk2(f, 0.f) & 0xffffu; }
__device__ __forceinline__ float wave_sum(float v) {
#pragma unroll
    for (int o = 1; o < 64; o <<= 1) v += __shfl_xor(v, o);
    return v;
}
__device__ __forceinline__ float sigmoid_f(float x) { return 1.0f / (1.0f + __expf(-x)); }
__device__ __forceinline__ float gelu_tanh_f(float x) {
    const float u = 0.7978845608028654f * (x + 0.044715f * x * x * x);
    const float t = 1.0f - 2.0f * __builtin_amdgcn_rcpf(1.0f + __expf(2.0f * u));
    return 0.5f * x * (1.0f + t);
}

struct Args { const float* in[18]; float* out; unsigned char* ws; int ph_lo, ph_hi; };

__device__ __forceinline__ void transpose_item(const float* W, int K, int N, bf16_t* WT, int k0, int n0, int dst_row0, LAS float* scr, int lane) {
    const int kk = lane >> 4, n4 = (lane & 15) * 4; f32x4 v[16];
#pragma unroll
    for (int i = 0; i < 16; ++i) v[i] = *(const f32x4*)(W + (size_t)(k0 + kk + 4 * i) * N + n0 + n4);
#pragma unroll
    for (int i = 0; i < 16; ++i) { LAS float* d = scr + (kk + 4 * i) * 65 + n4; d[0] = v[i][0]; d[1] = v[i][1]; d[2] = v[i][2]; d[3] = v[i][3]; }
    asm volatile("s_waitcnt lgkmcnt(0)" ::: "memory");
    const int c = lane & 7;
#pragma unroll
    for (int j = 0; j < 8; ++j) { const int n = (lane >> 3) + 8 * j; const LAS float* s = scr + (8 * c) * 65 + n;
        u32x4 o; o.x = pk2(s[0 * 65], s[1 * 65]); o.y = pk2(s[2 * 65], s[3 * 65]); o.z = pk2(s[4 * 65], s[5 * 65]); o.w = pk2(s[6 * 65], s[7 * 65]);
        *(u32x4*)(WT + (size_t)(dst_row0 + n) * K + k0 + 8 * c) = o; }
    asm volatile("s_waitcnt lgkmcnt(0)" ::: "memory");
}
__device__ __forceinline__ void convert_weights(const Args& a, int l, LAS unsigned char* lds, int gw, int NGW, int wave, int lane, int part) {
    LAS float* scr = (LAS float*)(lds + wave * 16640);
    const float* w_in = a.in[2] + (size_t)l * DM * INW; const float* w_out = a.in[12] + (size_t)l * DM * DM;
    const float* w_g = a.in[14] + (size_t)l * DM * DFF; const float* w_u = a.in[15] + (size_t)l * DM * DFF; const float* w_d = a.in[16] + (size_t)l * DFF * DM;
    bf16_t* WIN = (bf16_t*)(a.ws + WS_WIN); bf16_t* WOUT = (bf16_t*)(a.ws + WS_WOUT); bf16_t* WGU = (bf16_t*)(a.ws + WS_WGU); bf16_t* WDN = (bf16_t*)(a.ws + WS_WDN);
    constexpr int I_IN = (DM / 64) * (INW / 64), I_OUT = (DM / 64) * (DM / 64), I_G = (DM / 64) * (DFF / 64), I_D = (DFF / 64) * (DM / 64);
    constexpr int NITEMS = I_IN + I_OUT + 2 * I_G + I_D;
    const int it_lo = part == 2 ? I_IN + I_OUT : 0, it_hi = part == 1 ? I_IN + I_OUT : NITEMS;
    for (int it = it_lo + gw; it < it_hi; it += NGW) {
        int r = it; const float* W; bf16_t* WT; int K, N, dsel;
        if (r < I_IN) { W = w_in; WT = WIN; K = DM; N = INW; dsel = 0; }
        else if ((r -= I_IN) < I_OUT) { W = w_out; WT = WOUT; K = DM; N = DM; dsel = 0; }
        else if ((r -= I_OUT) < I_G) { W = w_g; WT = WGU; K = DM; N = DFF; dsel = 1; }
        else if ((r -= I_G) < I_G) { W = w_u; WT = WGU; K = DM; N = DFF; dsel = 2; }
        else { r -= I_G; W = w_d; WT = WDN; K = DFF; N = DM; dsel = 0; }
        const int nb = N / 64, kb = r / nb, n0 = (r % nb) * 64;
        const int dst = dsel == 0 ? n0 : (n0 >> 7) * 256 + (n0 & 127) + (dsel == 2 ? 128 : 0);
        transpose_item(W, K, N, WT, kb * 64, n0, dst, scr, lane);
    }
}
template <bool OUT_F32>
__device__ __forceinline__ void rmsnorm_rows(const float* X, const float* g, void* outp, int gw, int NGW, int lane) {
    f32x4 gv[8];
#pragma unroll
    for (int j = 0; j < 8; ++j) gv[j] = *(const f32x4*)(g + j * 256 + lane * 4);
    for (int m = gw; m < MTOK; m += NGW) {
        const float* xr = X + (size_t)m * DM; f32x4 v[8]; float s = 0.f;
#pragma unroll
        for (int j = 0; j < 8; ++j) { v[j] = *(const f32x4*)(xr + j * 256 + lane * 4); s += (v[j][0] * v[j][0] + v[j][1] * v[j][1]) + (v[j][2] * v[j][2] + v[j][3] * v[j][3]); }
        const float rs = 1.0f / sqrtf(wave_sum(s) * (1.0f / DM) + EPS);
        if (OUT_F32) { float* o = (float*)outp + (size_t)m * DM;
#pragma unroll
            for (int j = 0; j < 8; ++j) *(f32x4*)(o + j * 256 + lane * 4) = v[j] * rs * gv[j];
        } else { bf16_t* o = (bf16_t*)outp + (size_t)m * DM;
#pragma unroll
            for (int j = 0; j < 8; ++j) { const f32x4 y = v[j] * rs * gv[j]; u32x2 w; w.x = pk2(y[0], y[1]); w.y = pk2(y[2], y[3]); *(u32x2*)(o + j * 256 + lane * 4) = w; } }
    }
}
__device__ __forceinline__ void rope_table(float2* tab, int gtid, int NG) {
    for (int i = gtid; i < SEQ * 64; i += NG) { const int t = i >> 6, d = i & 63;
        const float inv = 1.0f / powf(10000.0f, (float)d * (1.0f / 64.0f)); const float ang = (float)t * inv;
        const double rev = (double)ang * 0.15915494309189535; const float fr = (float)(rev - floor(rev));
        tab[i] = make_float2(__builtin_amdgcn_cosf(fr), __builtin_amdgcn_sinf(fr)); }
}

typedef short bf16x8_t __attribute__((ext_vector_type(8)));
__device__ __forceinline__ unsigned off_b(unsigned row, unsigned ch) { return 256u * row + 16u * (ch ^ (((row & 3u) << 2) | ((row >> 2) & 3u))); }
typedef short s16x4 __attribute__((ext_vector_type(4)));
__device__ __forceinline__ unsigned tr_addr(unsigned R0, unsigned c, unsigned fr) { const unsigned q = fr >> 2, p = fr & 3; return off_b(R0 + q, 2 * c + (p >> 1)) + 8 * (p & 1); }
#define TR_READ2(d0, d1, a0, a1) asm volatile("ds_read_b64_tr_b16 %0, %2\n\tds_read_b64_tr_b16 %1, %3\n\ts_waitcnt lgkmcnt(0)" : "=&v"(d0), "=&v"(d1) : "v"(a0), "v"(a1) : "memory")
#define TR_READ4(d0, d1, d2, d3, a0, a1, a2, a3) asm volatile("ds_read_b64_tr_b16 %0, %4\n\tds_read_b64_tr_b16 %1, %5\n\tds_read_b64_tr_b16 %2, %6\n\tds_read_b64_tr_b16 %3, %7\n\ts_waitcnt lgkmcnt(0)" \
    : "=&v"(d0), "=&v"(d1), "=&v"(d2), "=&v"(d3) : "v"(a0), "v"(a1), "v"(a2), "v"(a3) : "memory")
template <int CTRL> __device__ __forceinline__ float dppf(float v) { return __int_as_float(__builtin_amdgcn_update_dpp(0, __float_as_int(v), CTRL, 0xf, 0xf, true)); }
__device__ __forceinline__ float row16_sum(float v) { v += dppf<0xB1>(v); v += dppf<0x4E>(v); v += dppf<0x141>(v); v += dppf<0x140>(v); return v; }
__device__ __forceinline__ bf16x8_t cat4(s16x4 a, s16x4 b) { return (bf16x8_t){a[0], a[1], a[2], a[3], b[0], b[1], b[2], b[3]}; }
__device__ __forceinline__ float ret_logg(int h) { return log1pf(-exp2f(-5.0f - (float)h)); }
__device__ __forceinline__ float bflo(unsigned w) { return __uint_as_float(w << 16); }
__device__ __forceinline__ float bfhi(unsigned w) { return __uint_as_float(w & 0xffff0000u); }
__device__ __forceinline__ void rope_apply(const u32x4 lo, const u32x4 hi, const f32x4 (&cs)[4], LAS unsigned char* img, int c, int ch, float scale) {
    float t1[8] = {bflo(lo.x), bfhi(lo.x), bflo(lo.y), bfhi(lo.y), bflo(lo.z), bfhi(lo.z), bflo(lo.w), bfhi(lo.w)};
    float t2[8] = {bflo(hi.x), bfhi(hi.x), bflo(hi.y), bfhi(hi.y), bflo(hi.z), bfhi(hi.z), bflo(hi.w), bfhi(hi.w)};
    float o1[8], o2[8];
#pragma unroll
    for (int k = 0; k < 4; ++k) {
        o1[2 * k] = (t1[2 * k] * cs[k][0] - t2[2 * k] * cs[k][1]) * scale; o2[2 * k] = (t1[2 * k] * cs[k][1] + t2[2 * k] * cs[k][0]) * scale;
        o1[2 * k + 1] = (t1[2 * k + 1] * cs[k][2] - t2[2 * k + 1] * cs[k][3]) * scale; o2[2 * k + 1] = (t1[2 * k + 1] * cs[k][3] + t2[2 * k + 1] * cs[k][2]) * scale; }
    u32x4 w1, w2; w1.x = pk2(o1[0], o1[1]); w1.y = pk2(o1[2], o1[3]); w1.z = pk2(o1[4], o1[5]); w1.w = pk2(o1[6], o1[7]);
    w2.x = pk2(o2[0], o2[1]); w2.y = pk2(o2[2], o2[3]); w2.z = pk2(o2[4], o2[5]); w2.w = pk2(o2[6], o2[7]);
    *(LAS u32x4*)(img + off_b(c, ch)) = w1; *(LAS u32x4*)(img + off_b(c, ch + 8)) = w2;
}
struct R1Regs { u32x4 klo, khi, v[2]; f32x4 cs[4]; };
__device__ __forceinline__ void ret1_load(R1Regs& r, const bf16_t* P, const float2* rope, int item, int tid) {
    const int b = item >> 8, n = (item >> 3) & 31, h = item & 7, row0 = b * SEQ + n * 64, c = tid >> 3, ch = tid & 7;
    const bf16_t* src = P + (size_t)(row0 + c) * INW + 1024 + h * 128; r.klo = *(const u32x4*)(src + 8 * ch); r.khi = *(const u32x4*)(src + 64 + 8 * ch);
    const float2* rp = rope + (n * 64 + c) * 64;
#pragma unroll
    for (int k = 0; k < 4; ++k) r.cs[k] = *(const f32x4*)(rp + 8 * ch + 2 * k);
#pragma unroll
    for (int k = 0; k < 2; ++k) { const int i = tid + NT * k; r.v[k] = *(const u32x4*)(P + (size_t)(row0 + (i >> 4)) * INW + 2048 + h * 128 + 8 * (i & 15)); }
}
__device__ __forceinline__ void ret_stage1_block(const Args& a, LAS unsigned char* lds, int bid, int G, int tid) {
    const bf16_t* P = (const bf16_t*)(a.ws + WS_P); const float2* rope = (const float2*)(a.ws + WS_ROPE); bf16_t* U = (bf16_t*)(a.ws + WS_U);
    LAS unsigned char* Ki = lds; LAS unsigned char* Vi = lds + 16384;
    const int lane = tid & 63, wave = tid >> 6, fr = lane & 15, fq = lane >> 4;
    const unsigned kb = (unsigned)(size_t)Ki, vb = (unsigned)(size_t)Vi;
    R1Regs rg;
    if (bid < 1024) ret1_load(rg, P, rope, bid, tid);
    for (int item = bid; item < 1024; item += G) {
        const int b = item >> 8, n = (item >> 3) & 31, h = item & 7; const float lg = ret_logg(h);
        { const int c = tid >> 3, ch = tid & 7; rope_apply(rg.klo, rg.khi, rg.cs, Ki, c, ch, 0.08838834764831845f * __expf(lg * (float)(63 - c)));
#pragma unroll
          for (int k = 0; k < 2; ++k) { const int i = tid + NT * k; *(LAS u32x4*)(Vi + off_b(i >> 4, i & 15)) = rg.v[k]; } }
        __syncthreads();
        if (item + G < 1024) ret1_load(rg, P, rope, item + G, tid);
        bf16x8_t af[2];
        { s16x4 x0, x1, x2, x3; TR_READ4(x0, x1, x2, x3, kb + tr_addr(8 * fq, wave, fr), kb + tr_addr(8 * fq + 4, wave, fr), kb + tr_addr(32 + 8 * fq, wave, fr), kb + tr_addr(32 + 8 * fq + 4, wave, fr)); af[0] = cat4(x0, x1); af[1] = cat4(x2, x3); }
        bf16_t* up = U + (size_t)((b * 8 + h) * 32 + n) * 16384 + (size_t)(16 * wave + fr) * 128 + 4 * fq;
#pragma unroll
        for (int eb = 0; eb < 8; ++eb) { f32x4 acc = (f32x4){0.f, 0.f, 0.f, 0.f};
            { s16x4 x0, x1, x2, x3; TR_READ4(x0, x1, x2, x3, vb + tr_addr(8 * fq, eb, fr), vb + tr_addr(8 * fq + 4, eb, fr), vb + tr_addr(32 + 8 * fq, eb, fr), vb + tr_addr(32 + 8 * fq + 4, eb, fr));
                acc = __builtin_amdgcn_mfma_f32_16x16x32_bf16(cat4(x0, x1), af[0], acc, 0, 0, 0); acc = __builtin_amdgcn_mfma_f32_16x16x32_bf16(cat4(x2, x3), af[1], acc, 0, 0, 0); }
            u32x2 w; w.x = pk2(acc[0], acc[1]); w.y = pk2(acc[2], acc[3]); *(u32x2*)(up + 16 * eb) = w; }
        __syncthreads();
    }
}
__device__ __forceinline__ void ret_scan(const Args& a, int gtid, int NG) {
    const u32x2* U4 = (const u32x2*)(a.ws + WS_U); u32x2* S2 = (u32x2*)(a.ws + WS_SB);
    for (int i = gtid; i < 32 * 4096; i += NG) { const int bh = i >> 12, q = i & 4095, h = bh & 7; const float dec = __expf(64.0f * ret_logg(h));
        const u32x2* ub = U4 + (size_t)bh * 32 * 4096 + q; u32x2* sb = S2 + (size_t)bh * 32 * 4096 + q; f32x4 s = (f32x4){0.f, 0.f, 0.f, 0.f};
#pragma unroll 8
        for (int n = 0; n < 32; ++n) { const u32x2 ur = ub[(size_t)n * 4096]; const f32x4 u = (f32x4){bflo(ur.x), bfhi(ur.x), bflo(ur.y), bfhi(ur.y)}; u32x2 w; w.x = pk2(s[0], s[1]); w.y = pk2(s[2], s[3]); sb[(size_t)n * 4096] = w; s = s * dec + u; } }
}
struct R3Regs { u32x4 qlo, qhi, klo, khi, v[2], sv[4]; f32x4 cs[4]; };
__device__ __forceinline__ void ret3_load(R3Regs& r, const bf16_t* P, const float2* rope, const bf16_t* SB, int item, int tid) {
    const int b = item >> 8, n = (item >> 3) & 31, h = item & 7, row0 = b * SEQ + n * 64, c = tid >> 3, ch = tid & 7;
    const bf16_t* pr = P + (size_t)(row0 + c) * INW + h * 128;
    r.qlo = *(const u32x4*)(pr + 8 * ch); r.qhi = *(const u32x4*)(pr + 64 + 8 * ch); r.klo = *(const u32x4*)(pr + 1024 + 8 * ch); r.khi = *(const u32x4*)(pr + 1024 + 64 + 8 * ch);
    const float2* rp = rope + (n * 64 + c) * 64;
#pragma unroll
    for (int k = 0; k < 4; ++k) r.cs[k] = *(const f32x4*)(rp + 8 * ch + 2 * k);
#pragma unroll
    for (int k = 0; k < 2; ++k) { const int i = tid + NT * k; const bf16_t* vr = P + (size_t)(row0 + (i >> 4)) * INW + h * 128 + 8 * (i & 15); r.v[k] = *(const u32x4*)(vr + 2048); }
    const bf16_t* sp = SB + (size_t)((b * 8 + h) * 32 + n) * 16384;
#pragma unroll
    for (int k = 0; k < 4; ++k) { const int i = tid + NT * k; r.sv[k] = *(const u32x4*)(sp + (size_t)(i >> 4) * 128 + 8 * (i & 15)); }
}
__device__ __forceinline__ void ret_stage3_block(const Args& a, int l, LAS unsigned char* lds, int bid, int G, int tid) {
    const bf16_t* P = (const bf16_t*)(a.ws + WS_P); const float2* rope = (const float2*)(a.ws + WS_ROPE); const bf16_t* SB = (const bf16_t*)(a.ws + WS_SB);
    bf16_t* MIX = (bf16_t*)(a.ws + WS_MIX); const float* gn_g = a.in[3] + l * RW;
    LAS unsigned char* Qi = lds; LAS unsigned char* Ki = lds + 16384; LAS unsigned char* Vi = lds + 32768; LAS unsigned char* Si = lds + 49152; LAS float* part = (LAS float*)(lds + 81920);
    const int lane = tid & 63, wave = tid >> 6, fr = lane & 15, fq = lane >> 4;
    R3Regs rg;
    if (bid < 1024) ret3_load(rg, P, rope, SB, bid, tid);
  for (int item = bid; item < 1024; item += G) {
    const int b = item >> 8, n = (item >> 3) & 31, h = item & 7, row0 = b * SEQ + n * 64; const float lg = ret_logg(h);
    { const int c = tid >> 3, ch = tid & 7; rope_apply(rg.qlo, rg.qhi, rg.cs, Qi, c, ch, 1.0f); rope_apply(rg.klo, rg.khi, rg.cs, Ki, c, ch, 0.08838834764831845f);
#pragma unroll
      for (int k = 0; k < 2; ++k) { const int i = tid + NT * k; *(LAS u32x4*)(Vi + off_b(i >> 4, i & 15)) = rg.v[k]; }
#pragma unroll
      for (int k = 0; k < 4; ++k) { const int i = tid + NT * k; *(LAS u32x4*)(Si + off_b(i >> 4, i & 15)) = rg.sv[k]; } }
    __syncthreads();
    u32x4 gpre[2];
#pragma unroll
    for (int k = 0; k < 2; ++k) { const int i = tid + NT * k; gpre[k] = *(const u32x4*)(P + (size_t)(row0 + (i >> 4)) * INW + 3072 + h * 128 + 8 * (i & 15)); }
    if (item + G < 1024) ret3_load(rg, P, rope, SB, item + G, tid);
    const int ab = wave & 3, eh = wave >> 2;
    const unsigned vb = (unsigned)(size_t)Vi, sbs = (unsigned)(size_t)Si;
    bf16x8_t qf[4];
#pragma unroll
    for (int ks = 0; ks < 4; ++ks) qf[ks] = *(const LAS bf16x8_t*)(Qi + off_b(16 * ab + fr, 4 * ks + fq));
    unsigned sp[4][2];
#pragma unroll
    for (int cb = 0; cb < 4; ++cb) { f32x4 acc = (f32x4){0.f, 0.f, 0.f, 0.f};
#pragma unroll
        for (int ks = 0; ks < 4; ++ks) { const bf16x8_t kf = *(const LAS bf16x8_t*)(Ki + off_b(16 * cb + fr, 4 * ks + fq)); acc = __builtin_amdgcn_mfma_f32_16x16x32_bf16(kf, qf[ks], acc, 0, 0, 0); }
        float d[4];
#pragma unroll
        for (int r = 0; r < 4; ++r) d[r] = acc[r] * __expf(lg * fabsf((float)(16 * ab + fr - (16 * cb + 4 * fq + r))));
        sp[cb][0] = pk2(d[0], d[1]); sp[cb][1] = pk2(d[2], d[3]); }
    f32x4 oi[4], oc[4];
#pragma unroll
    for (int e = 0; e < 4; ++e) { const int eb = 4 * eh + e; oi[e] = (f32x4){0.f, 0.f, 0.f, 0.f}; oc[e] = (f32x4){0.f, 0.f, 0.f, 0.f};
        {
            s16x4 x0, x1, x2, x3; TR_READ4(x0, x1, x2, x3, vb + tr_addr(4 * fq, eb, fr), vb + tr_addr(16 + 4 * fq, eb, fr), vb + tr_addr(32 + 4 * fq, eb, fr), vb + tr_addr(48 + 4 * fq, eb, fr));
            u32x4 aw; aw.x = sp[0][0]; aw.y = sp[0][1]; aw.z = sp[1][0]; aw.w = sp[1][1];
            oi[e] = __builtin_amdgcn_mfma_f32_16x16x32_bf16(__builtin_bit_cast(bf16x8_t, aw), cat4(x0, x1), oi[e], 0, 0, 0);
            aw.x = sp[2][0]; aw.y = sp[2][1]; aw.z = sp[3][0]; aw.w = sp[3][1];
            oi[e] = __builtin_amdgcn_mfma_f32_16x16x32_bf16(__builtin_bit_cast(bf16x8_t, aw), cat4(x2, x3), oi[e], 0, 0, 0); }
#pragma unroll
        for (int kp = 0; kp < 2; ++kp) { s16x4 x0, x1, x2, x3;
            TR_READ4(x0, x1, x2, x3, sbs + tr_addr(64 * kp + 8 * fq, eb, fr), sbs + tr_addr(64 * kp + 8 * fq + 4, eb, fr), sbs + tr_addr(64 * kp + 32 + 8 * fq, eb, fr), sbs + tr_addr(64 * kp + 32 + 8 * fq + 4, eb, fr));
            oc[e] = __builtin_amdgcn_mfma_f32_16x16x32_bf16(qf[2 * kp], cat4(x0, x1), oc[e], 0, 0, 0);
            oc[e] = __builtin_amdgcn_mfma_f32_16x16x32_bf16(qf[2 * kp + 1], cat4(x2, x3), oc[e], 0, 0, 0); } }
    float s1[4], s2[4];
#pragma unroll
    for (int r = 0; r < 4; ++r) { const float qd = __expf(lg * (float)(16 * ab + 4 * fq + r + 1)); s1[r] = 0.f; s2[r] = 0.f;
#pragma unroll
        for (int e = 0; e < 4; ++e) { const float v = oi[e][r] + qd * oc[e][r]; oi[e][r] = v; s1[r] += v; s2[r] += v * v; } }
#pragma unroll
    for (int r = 0; r < 4; ++r) { s1[r] = row16_sum(s1[r]); s2[r] = row16_sum(s2[r]);
        if (fr == 0) { part[(eh * 64 + 16 * ab + 4 * fq + r) * 2] = s1[r]; part[(eh * 64 + 16 * ab + 4 * fq + r) * 2 + 1] = s2[r]; } }
    __syncthreads();
    LAS bf16_t* Y = (LAS bf16_t*)lds;
    float gnv[4];
#pragma unroll
    for (int e = 0; e < 4; ++e) gnv[e] = gn_g[h * 128 + 16 * (4 * eh + e) + fr];
#pragma unroll
    for (int r = 0; r < 4; ++r) { const int aa = 16 * ab + 4 * fq + r;
        const float t1 = part[aa * 2] + part[(64 + aa) * 2], t2 = part[aa * 2 + 1] + part[(64 + aa) * 2 + 1];
        const float mu = t1 * (1.0f / 128.0f), var = fmaxf(t2 * (1.0f / 128.0f) - mu * mu, 0.f), rstd = 1.0f / sqrtf(var + EPS);
#pragma unroll
        for (int e = 0; e < 4; ++e) Y[aa * 136 + 16 * (4 * eh + e) + fr] = (bf16_t)f2bf((oi[e][r] - mu) * rstd * gnv[e]); }
    __syncthreads();
#pragma unroll
    for (int k = 0; k < 2; ++k) { const int c = tid + NT * k, row = c >> 4, ch = c & 15;
        const u32x4 yv = *(const LAS u32x4*)(Y + row * 136 + 8 * ch); const u32x4 gv = gpre[k]; u32x4 w;
        w.x = pk2(bflo(yv.x) * pg8::silu_f(bflo(gv.x)), bfhi(yv.x) * pg8::silu_f(bfhi(gv.x))); w.y = pk2(bflo(yv.y) * pg8::silu_f(bflo(gv.y)), bfhi(yv.y) * pg8::silu_f(bfhi(gv.y)));
        w.z = pk2(bflo(yv.z) * pg8::silu_f(bflo(gv.z)), bfhi(yv.z) * pg8::silu_f(bfhi(gv.z))); w.w = pk2(bflo(yv.w) * pg8::silu_f(bflo(gv.w)), bfhi(yv.w) * pg8::silu_f(bfhi(gv.w)));
        *(u32x4*)(MIX + (size_t)(row0 + row) * DM + h * 128 + 8 * ch) = w; }
    __syncthreads();
  }
}

__device__ __forceinline__ void lru_gate_weights(const Args& a, int gtid, int NG) {
    bf16_t* WAT = (bf16_t*)(a.ws + WS_WAT);
    for (int idx = gtid; idx < 2 * 16 * 2 * 4096; idx += NG) { const int i = idx & 63, j = (idx >> 6) & 63, gate = (idx >> 12) & 1, lg = idx >> 13;
        const float* w = (gate ? a.in[8] : a.in[6]) + (size_t)lg * 4096; WAT[idx] = (bf16_t)f2bf(w[i * 64 + j]); }
}
constexpr int XBS = 72;
__device__ __forceinline__ void lru_stage1_block(const Args& a, int l, LAS unsigned char* lds, int bid, int G, int tid) {
    const bf16_t* P = (const bf16_t*)(a.ws + WS_P);
    bf16_t* HL = (bf16_t*)(a.ws + WS_HL); bf16_t* ACUM = (bf16_t*)(a.ws + WS_ACUM); float* APROD = (float*)(a.ws + WS_APROD); float* HEND = (float*)(a.ws + WS_HEND);
    const float* conv_w = a.in[4] + l * 4 * LW; const float* conv_b = a.in[5] + l * LW; const float* ba = a.in[7] + l * LW; const float* bx = a.in[9] + l * LW; const float* lam = a.in[10] + l * LW;
    const bf16_t* WAT = (const bf16_t*)(a.ws + WS_WAT) + (size_t)l * 16 * 2 * 4096;
    LAS bf16_t* XB = (LAS bf16_t*)lds;
    LAS bf16_t* WT = XB + 64 * XBS;
    LAS float* XF = (LAS float*)(WT + 2 * 64 * XBS);
    LAS float* As = XF + 64 * 65; LAS float* Bs = As + 64 * 65; LAS float* segP = Bs + 64 * 65; LAS float* segH = segP + 512;
    const int lane = tid & 63, wave = tid >> 6, fr = lane & 15, fq = lane >> 4;
    const int per = (2048 + G - 1) / G; const int it_end = (bid + 1) * per < 2048 ? (bid + 1) * per : 2048;
    int gl = -1, gc = -1; float spv[2] = {0.f, 0.f}, bav[2] = {0.f, 0.f}, bxv[2] = {0.f, 0.f};
    const int j4 = (tid & 15) * 4;
    u32x2 xr[2][4];
#define LRU_LOADX(IT) do { const int bn_ = (IT) & 127, b_ = bn_ >> 5, n_ = bn_ & 31, c0_ = ((IT) >> 7) * 64; \
        _Pragma("unroll") for (int k = 0; k < 2; ++k) _Pragma("unroll") for (int q = 0; q < 4; ++q) { const int tt = n_ * 64 + (tid >> 4) + 32 * k + q - 3; \
            xr[k][q] = tt >= 0 ? *(const u32x2*)(P + (size_t)(b_ * SEQ + tt) * INW + 4096 + c0_ + j4) : (u32x2){0u, 0u}; } } while (0)
    if (bid * per < it_end) LRU_LOADX(bid * per);
    for (int it = bid * per; it < it_end; ++it) {
        const int g = it >> 7, bn = it & 127, b = bn >> 5, n = bn & 31, row0 = b * SEQ + n * 64, ch0 = g * 64;
        if (g != gl) { gl = g;
#pragma unroll
            for (int k = 0; k < 2; ++k) { const int c = tid + NT * k, gate = c >> 9, jr = (c >> 3) & 63, ic = (c & 7) * 8;
                *(LAS u32x4*)(WT + (gate * 64 + jr) * XBS + ic) = *(const u32x4*)(WAT + ((size_t)(g * 2 + gate) * 64 + jr) * 64 + ic); } }
        {
            f32x4 cw[4];
#pragma unroll
            for (int q = 0; q < 4; ++q) cw[q] = *(const f32x4*)(conv_w + q * LW + ch0 + j4);
            const f32x4 cb = *(const f32x4*)(conv_b + ch0 + j4);
#pragma unroll
            for (int k = 0; k < 2; ++k) { const int t = (tid >> 4) + 32 * k; f32x4 v = cb;
#pragma unroll
                for (int q = 0; q < 4; ++q) { const u32x2 r = xr[k][q];
                    v[0] += cw[q][0] * __uint_as_float(r.x << 16); v[1] += cw[q][1] * __uint_as_float(r.x & 0xffff0000u); v[2] += cw[q][2] * __uint_as_float(r.y << 16); v[3] += cw[q][3] * __uint_as_float(r.y & 0xffff0000u); }
                XF[t * 65 + j4] = v[0]; XF[t * 65 + j4 + 1] = v[1]; XF[t * 65 + j4 + 2] = v[2]; XF[t * 65 + j4 + 3] = v[3];
                u32x2 w; w.x = pk2(v[0], v[1]); w.y = pk2(v[2], v[3]); *(LAS u32x2*)(XB + t * XBS + j4) = w; }
        }
        if (it + 1 < it_end) LRU_LOADX(it + 1);
        __syncthreads();
        {
            const int tb = wave & 3, jp = wave >> 2; f32x4 acc[2][2];
#pragma unroll
            for (int ga = 0; ga < 2; ++ga)
#pragma unroll
                for (int jj = 0; jj < 2; ++jj) acc[ga][jj] = (f32x4){0.f, 0.f, 0.f, 0.f};
#pragma unroll
            for (int ks = 0; ks < 2; ++ks) { const bf16x8_t af = *(const LAS bf16x8_t*)(XB + (16 * tb + fr) * XBS + ks * 32 + 8 * fq);
#pragma unroll
                for (int ga = 0; ga < 2; ++ga)
#pragma unroll
                    for (int jj = 0; jj < 2; ++jj) { const bf16x8_t bfr = *(const LAS bf16x8_t*)(WT + (ga * 64 + 16 * (2 * jp + jj) + fr) * XBS + ks * 32 + 8 * fq);
                        acc[ga][jj] = __builtin_amdgcn_mfma_f32_16x16x32_bf16(af, bfr, acc[ga][jj], 0, 0, 0); } }
#pragma unroll
            for (int jj = 0; jj < 2; ++jj) { const int j = 16 * (2 * jp + jj) + fr;
                if (g != gc) { spv[jj] = -8.0f * log1pf(__expf(-lam[ch0 + j])); bav[jj] = ba[ch0 + j]; bxv[jj] = bx[ch0 + j]; }
#pragma unroll
                for (int r = 0; r < 4; ++r) { const int t = 16 * tb + 4 * fq + r;
                    const float rg = __builtin_amdgcn_rcpf(1.0f + __expf(-(acc[0][jj][r] + bav[jj]))), ig = __builtin_amdgcn_rcpf(1.0f + __expf(-(acc[1][jj][r] + bxv[jj])));
                    const float av = __expf(rg * spv[jj]);
                    As[t * 65 + j] = av; Bs[t * 65 + j] = sqrtf(fmaxf(1.0f - av * av, 0.f)) * (ig * XF[t * 65 + j]); } }
            gc = g;
        }
        __syncthreads();
        {
            const int sg = wave, j = lane; float av[8], bv[8];
#pragma unroll
            for (int k = 0; k < 8; ++k) { av[k] = As[(8 * sg + k) * 65 + j]; bv[k] = Bs[(8 * sg + k) * 65 + j]; }
            float pp = 1.f, hh = 0.f;
#pragma unroll
            for (int k = 0; k < 8; ++k) { hh = av[k] * hh + bv[k]; pp *= av[k]; }
            segP[sg * 64 + j] = pp; segH[sg * 64 + j] = hh;
            __syncthreads();
            float hc = 0.f, pc = 1.f;
#pragma unroll
            for (int q = 0; q < 7; ++q) { const float p2 = segP[q * 64 + j], h2 = segH[q * 64 + j]; if (q < sg) { hc = p2 * hc + h2; pc *= p2; } }
#pragma unroll
            for (int k = 0; k < 8; ++k) { hc = av[k] * hc + bv[k]; pc *= av[k]; const size_t o = (size_t)(row0 + 8 * sg + k) * LW + ch0 + j; HL[o] = (bf16_t)f2bf(hc); ACUM[o] = (bf16_t)f2bf(pc); }
            if (sg == 7) { APROD[(b * 32 + n) * LW + ch0 + j] = pc; HEND[(b * 32 + n) * LW + ch0 + j] = hc; }
        }
    }
    __syncthreads();
#undef LRU_LOADX
}
__device__ __forceinline__ void lru_carry_scan(const Args& a, int gtid) {
    const float* APROD = (const float*)(a.ws + WS_APROD); const float* HEND = (const float*)(a.ws + WS_HEND); float* CARRY = (float*)(a.ws + WS_CARRY);
    if (gtid < 4 * LW) { const int b = gtid >> 10, ch = gtid & 1023; float c = 0.f;
        float av[32], hv[32];
#pragma unroll
        for (int n = 0; n < 32; ++n) { const int o = (b * 32 + n) * LW + ch; av[n] = APROD[o]; hv[n] = HEND[o]; }
#pragma unroll
        for (int n = 0; n < 32; ++n) { CARRY[(b * 32 + n) * LW + ch] = c; c = av[n] * c + hv[n]; } }
}
__device__ __forceinline__ void lru_stage3(const Args& a, int l, int gw, int NGW, int lane) {
    const bf16_t* P = (const bf16_t*)(a.ws + WS_P); bf16_t* MIX = (bf16_t*)(a.ws + WS_MIX);
    const bf16_t* HL = (const bf16_t*)(a.ws + WS_HL); const bf16_t* ACUM = (const bf16_t*)(a.ws + WS_ACUM); const float* CARRY = (const float*)(a.ws + WS_CARRY);
    const float* norm_g = a.in[11] + l * LW;
    for (int tb = gw; tb < MTOK; tb += 4 * NGW) {
        f32x4 y[4][4]; float ss[4];
#pragma unroll
        for (int u = 0; u < 4; ++u) { const int t = (tb + u * NGW < MTOK) ? tb + u * NGW : tb, b = t >> 11, n = (t >> 6) & 31; ss[u] = 0.f;
#pragma unroll
            for (int k = 0; k < 4; ++k) { const int ch = k * 256 + lane * 4;
                const u32x2 hr = *(const u32x2*)(HL + (size_t)t * LW + ch), ar = *(const u32x2*)(ACUM + (size_t)t * LW + ch); const f32x4 cr = *(const f32x4*)(CARRY + (b * 32 + n) * LW + ch);
                const f32x4 hl = (f32x4){bflo(hr.x), bfhi(hr.x), bflo(hr.y), bfhi(hr.y)}, ac = (f32x4){bflo(ar.x), bfhi(ar.x), bflo(ar.y), bfhi(ar.y)};
                const u32x2 yr = *(const u32x2*)(P + (size_t)t * INW + 5120 + ch);
                const f32x4 hv = hl + ac * cr;
                y[u][k][0] = hv[0] * gelu_tanh_f(bflo(yr.x)); y[u][k][1] = hv[1] * gelu_tanh_f(bfhi(yr.x)); y[u][k][2] = hv[2] * gelu_tanh_f(bflo(yr.y)); y[u][k][3] = hv[3] * gelu_tanh_f(bfhi(yr.y));
                ss[u] += (y[u][k][0] * y[u][k][0] + y[u][k][1] * y[u][k][1]) + (y[u][k][2] * y[u][k][2] + y[u][k][3] * y[u][k][3]); } }
#pragma unroll
        for (int u = 0; u < 4; ++u) { const int t = (tb + u * NGW < MTOK) ? tb + u * NGW : tb; const float rs = 1.0f / sqrtf(wave_sum(ss[u]) * (1.0f / LW) + EPS);
#pragma unroll
            for (int k = 0; k < 4; ++k) { const int ch = k * 256 + lane * 4; const f32x4 gv = *(const f32x4*)(norm_g + ch); const f32x4 z = y[u][k] * rs * gv;
                u32x2 w; w.x = pk2(z[0], z[1]); w.y = pk2(z[2], z[3]); *(u32x2*)(MIX + (size_t)t * DM + 1024 + ch) = w; } } }
}

#define XB_TMO      128
#define XB_XCNT(j)  (256  + 64 * (j))
#define XB_XSUB(j)  (1280 + 64 * (j))
#define XB_XGEN(j)  (2304 + 64 * (j))
#define XB_TOP      3328
#define XB_TOPGEN   3392
#define XCD_BAR_WORDS 3456
#define XB_SPIN_CAP (1u << 18)

__device__ __forceinline__ unsigned xb_ld(unsigned* p)              { return __hip_atomic_load(p, __ATOMIC_RELAXED, __HIP_MEMORY_SCOPE_AGENT); }
__device__ __forceinline__ unsigned xb_add(unsigned* p, unsigned v) { return __hip_atomic_fetch_add(p, v, __ATOMIC_RELAXED, __HIP_MEMORY_SCOPE_AGENT); }
__device__ __forceinline__ unsigned xb_xcc_id() { return (unsigned)__builtin_amdgcn_s_getreg((3 << 11) | 20) & 0xFu; }
#define XB_SPIN(cond, bar) do { unsigned _sp = 0; while (cond) { __builtin_amdgcn_s_sleep(1); \
    if ((++_sp & 255u) == 0u) { if (xb_ld(&(bar)[XB_TMO])) break; if (_sp > XB_SPIN_CAP) { atomicAdd(&(bar)[XB_TMO], 1u); break; } } } } while (0)

struct XcdBarrier {
    unsigned* bar; unsigned x;
    volatile LAS unsigned* st;
};

__device__ __forceinline__ XcdBarrier xcd_barrier_post(unsigned* bar, volatile LAS unsigned* st) {
    XcdBarrier b; b.bar = bar; b.x = xb_xcc_id(); b.st = st;
    if (threadIdx.x == 0) (void)xb_add(&bar[XB_XCNT(b.x)], 1u);
    return b;
}
__device__ __forceinline__ void xcd_barrier_complete(unsigned* bar, unsigned x, unsigned& nloc, unsigned& nx) {
    const unsigned G = gridDim.x * gridDim.y * gridDim.z;
    unsigned sum, cnt, mine, sp = 0u;
    for (;;) {
        sum = 0u; cnt = 0u; mine = 0u;
#pragma unroll
        for (unsigned j = 0; j < 16; ++j) { const unsigned c = xb_ld(&bar[XB_XCNT(j)]); sum += c; cnt += (c > 0u) ? 1u : 0u; mine = (j == x) ? c : mine; }
        if (sum == G) break;
        __builtin_amdgcn_s_sleep(1);
        if ((++sp & 255u) == 0u) { if (xb_ld(&bar[XB_TMO])) break; if (sp > XB_SPIN_CAP) { atomicAdd(&bar[XB_TMO], 1u); break; } }
    }
    nloc = mine > 0u ? mine : 1u; nx = cnt > 0u ? cnt : 1u;
}

__device__ __forceinline__ void xcd_barrier(const XcdBarrier& b) {
    asm volatile("s_waitcnt vmcnt(0)" ::: "memory");
    __syncthreads();
    if (threadIdx.x == 0) {
        unsigned* bar = b.bar;
        __builtin_amdgcn_s_waitcnt(0);
        unsigned nloc = b.st[0], nx = b.st[1];
        if (nloc == 0u) { xcd_barrier_complete(bar, b.x, nloc, nx); b.st[0] = nloc; b.st[1] = nx; }
        const unsigned old = xb_add(&bar[XB_XSUB(b.x)], 1u);
        const unsigned gen = old / nloc;
        if (old + 1u == (gen + 1u) * nloc) {
            __builtin_amdgcn_fence(__ATOMIC_RELEASE, "agent");
            asm volatile("s_waitcnt vmcnt(0)" ::: "memory");
            const unsigned og = xb_add(&bar[XB_TOP], 1u);
            const unsigned tg = og / nx;
            if (og + 1u == (tg + 1u) * nx) xb_add(&bar[XB_TOPGEN], 1u);
            else XB_SPIN(xb_ld(&bar[XB_TOPGEN]) == tg, bar);
            __builtin_amdgcn_fence(__ATOMIC_ACQUIRE, "agent");
            xb_add(&bar[XB_XGEN(b.x)], 1u);
            asm volatile("s_waitcnt vmcnt(0)" ::: "memory");
        } else {
            XB_SPIN(xb_ld(&bar[XB_XGEN(b.x)]) == gen, bar);
            __builtin_amdgcn_fence(__ATOMIC_ACQUIRE, "agent");
            asm volatile("s_waitcnt vmcnt(0)" ::: "memory");
        }
    }
    __syncthreads();
}


constexpr int NPHASE = 16;
template <bool COOP>
__global__ void __launch_bounds__(NT, 2) hybrid_fwd(Args a) {
    extern __shared__ __attribute__((aligned(16))) unsigned char lds_raw[];
    LAS unsigned char* lds = (LAS unsigned char*)lds_raw;
    const int bid = blockIdx.x;
    bf16_t* WIN = (bf16_t*)(a.ws + WS_WIN); bf16_t* WOUT = (bf16_t*)(a.ws + WS_WOUT); bf16_t* WGU = (bf16_t*)(a.ws + WS_WGU); bf16_t* WDN = (bf16_t*)(a.ws + WS_WDN);
    bf16_t* PB = (bf16_t*)(a.ws + WS_P); bf16_t* MIX = (bf16_t*)(a.ws + WS_MIX); bf16_t* HB = (bf16_t*)(a.ws + WS_H);
    const unsigned long long pc0 = (unsigned long long)__builtin_amdgcn_s_getpc() & ~0xFFFull;
    const float* x_in = a.in[0]; float* XR = a.out; float* SLOTS = (float*)(a.ws + WS_SLOTS); unsigned* CNT = (unsigned*)(a.ws + WS_CNT);
    XcdBarrier xb; xb.bar = (unsigned*)(a.ws + WS_BAR); xb.x = 0; xb.st = nullptr;
    {
        volatile LAS unsigned* st = (volatile LAS unsigned*)(lds + LDS_BYTES - 16);
        if (threadIdx.x < 4) st[threadIdx.x] = 0u;
        if (a.ph_lo == 0 && bid == 0) {
            for (int i = threadIdx.x; i < XCD_BAR_WORDS; i += NT) ((unsigned*)(a.ws + WS_BAR))[i] = 0u;
            for (int i = threadIdx.x; i < 4 * 512; i += NT) ((unsigned*)(a.ws + WS_CNT))[i] = 0u; }
        __syncthreads();
    }
    for (int ph = a.ph_lo; ph < a.ph_hi; ++ph) {
        const int l = (ph - 1) / 8, sp = (ph == 0) ? -1 : (ph - 1) % 8;
        int tid_ = threadIdx.x; asm volatile("" : "+v"(tid_));
        int G_ = gridDim.x; asm volatile("" : "+s"(G_)); const int G = G_, NGW = G * 8, NG = G * NT;
        const int tid = tid_, lane = tid & 63, wave = __builtin_amdgcn_readfirstlane(tid >> 6), gw = bid * 8 + wave, gtid = bid * NT + tid;
        if (wave < 4) __builtin_amdgcn_global_load_lds((const unsigned*)(pc0 + (unsigned long long)(((bid >> 3) & 31) * 4096 + wave * 1024 + lane * 16)), (LAS unsigned*)(lds + 134144), 16, 0, 0);
        if (ph == 0) {
            convert_weights(a, 0, lds, gw, NGW, wave, lane, 0);
            rope_table((float2*)(a.ws + WS_ROPE), gtid, NG);
            lru_gate_weights(a, gtid, NG);
            rmsnorm_rows<false>(x_in, a.in[1], HB, gw, NGW, lane);
        } else if (sp == 0) {
            pg8::Gemm g{HB, WIN, MTOK, INW, DM}; pg8::StaticOrder S; S.init(MTOK, INW, G, bid); pg8::EpiBf16 E{PB, INW};
            pg8::gemm_phase<pg8::EpiBf16, pg8::StaticOrder, true, true>(lds, g, S, E);
        } else if (sp == 1) {
            ret_stage1_block(a, lds, bid, G, tid);
            lru_stage1_block(a, l, lds, bid, G, tid);
        } else if (sp == 2) {
            lru_carry_scan(a, gtid);
            ret_scan(a, gtid, NG);
        } else if (sp == 3) {
            ret_stage3_block(a, l, lds, bid, G, tid);
            lru_stage3(a, l, gw, NGW, lane);
        } else if (sp == 4) {
            pg8::Gemm g{MIX, WOUT, MTOK, DM, DM}; pg8::StaticOrder S; S.init(MTOK, DM, G, bid);
            pg8::EpiResNorm<false> E{l == 0 ? x_in : XR, XR, HB, a.in[13] + l * DM, SLOTS + (size_t)(2 * l) * MTOK * 8, CNT + (2 * l) * 512};
            pg8::gemm_phase<pg8::EpiResNorm<false>, pg8::StaticOrder, true, true>(lds, g, S, E);
        } else if (sp == 5) {
            pg8::Gemm g{HB, WGU, MTOK, 2 * DFF, DM}; pg8::StaticOrder S; S.init(MTOK, 2 * DFF, G, bid); pg8::EpiSwiglu E{PB, DFF};
            pg8::gemm_phase<pg8::EpiSwiglu, pg8::StaticOrder, true, true>(lds, g, S, E);
            if (l == 0) { const int nt_all = (MTOK / 256) * (2 * DFF / 256), rem = nt_all % G;
                if (rem != 0 && bid >= rem) { __syncthreads(); convert_weights(a, 1, lds, (bid - rem) * 8 + wave, (G - rem) * 8, wave, lane, 1); }
                else if (rem == 0) { __syncthreads(); convert_weights(a, 1, lds, gw, NGW, wave, lane, 1); } }
        } else if (sp == 6) {
            pg8::Gemm g{PB, WDN, MTOK, DM, DFF}; pg8::StaticOrder S; S.init(MTOK, DM, G, bid);
            if (l == 0) { pg8::EpiResNorm<false> E{XR, XR, HB, a.in[1] + DM, SLOTS + (size_t)MTOK * 8, CNT + 512}; pg8::gemm_phase<pg8::EpiResNorm<false>, pg8::StaticOrder, true, true>(lds, g, S, E); }
            else { pg8::EpiResNorm<true> E{XR, XR, HB, a.in[17], SLOTS + (size_t)3 * MTOK * 8, CNT + 3 * 512}; pg8::gemm_phase<pg8::EpiResNorm<true>, pg8::StaticOrder, true, true>(lds, g, S, E); }
        } else {
            convert_weights(a, 1, lds, gw, NGW, wave, lane, 2);
        }
        if (COOP) { if (ph + 1 < a.ph_hi) { if (ph == 0) { cg::this_grid().sync(); xb = xcd_barrier_post((unsigned*)(a.ws + WS_BAR), (volatile LAS unsigned*)(lds + LDS_BYTES - 16)); } else xcd_barrier(xb); } }
        else __syncthreads();
    }
}

extern "C" void kernel_launch(void* const* d_in, const int* in_sizes, int n_in, void* d_out, int out_size, void* d_ws, size_t ws_size, hipStream_t stream) {
    static int grid = 0;
    if (grid == 0) {
        if (n_in != 18 || out_size != MTOK * DM || ws_size < WS_END) { fprintf(stderr, "kernel_launch: unexpected shapes (n_in %d out %d ws %zu)\n", n_in, out_size, ws_size); grid = -1; return; }
        int dev = 0, cus = 0, per_cu = 0;
        hipGetDevice(&dev); hipDeviceGetAttribute(&cus, hipDeviceAttributeMultiprocessorCount, dev);
        hipFuncSetAttribute((const void*)hybrid_fwd<true>, hipFuncAttributeMaxDynamicSharedMemorySize, LDS_BYTES);
        hipFuncSetAttribute((const void*)hybrid_fwd<false>, hipFuncAttributeMaxDynamicSharedMemorySize, LDS_BYTES);
        hipOccupancyMaxActiveBlocksPerMultiprocessor(&per_cu, (const void*)hybrid_fwd<true>, NT, LDS_BYTES);
        if (per_cu < 1) { fprintf(stderr, "kernel_launch: occupancy query says %d blocks per CU\n", per_cu); per_cu = 1; }
        (void)hipGetLastError();
        grid = cus * 1;
    }
    if (grid < 0) return;
    Args a{};
    for (int i = 0; i < 18; ++i) a.in[i] = (const float*)d_in[i];
    a.out = (float*)d_out; a.ws = (unsigned char*)d_ws;
#if MEGA
    a.ph_lo = 0; a.ph_hi = NPHASE;
    void* args[] = {&a};
    hipError_t e = hipLaunchCooperativeKernel((const void*)hybrid_fwd<true>, dim3(grid), dim3(NT), args, LDS_BYTES, stream);
    if (e != hipSuccess) fprintf(stderr, "cooperative launch failed: %s (grid %d)\n", hipGetErrorString(e), grid);
#else
    for (int ph = 0; ph < NPHASE; ++ph) { a.ph_lo = ph; a.ph_hi = ph + 1; hipLaunchKernelGGL(hybrid_fwd<false>, dim3(grid), dim3(NT), LDS_BYTES, stream, a); }
#endif
}
```

```cpp
#include <hip/hip_runtime.h>
#include <hip/hip_cooperative_groups.h>
#include <cstdio>
#include <cstdint>
namespace cg = cooperative_groups;

#ifndef MEGA
#define MEGA 1
#endif

namespace pg8 {
#define PG8_LAS __attribute__((address_space(3)))
typedef unsigned short bf16_t;
typedef short bf16x8 __attribute__((ext_vector_type(8)));
typedef float f32x4 __attribute__((ext_vector_type(4)));
typedef unsigned u32x4 __attribute__((ext_vector_type(4)));
typedef unsigned u32x2 __attribute__((ext_vector_type(2)));
constexpr int BM = 256, BK = 64, HALF = 128, HTB = HALF * BK * 2  , STAGE_BYTES = 8 * HTB, NXCD = 8, WGM = 8;

__host__ __device__ __forceinline__ int lds_byte(int r, int c) { const int st = (r >> 4) * 2 + (c >> 5), rr = r & 15, cc = c & 31, ob = rr * 64 + cc * 2; return st * 1024 + (ob ^ (((ob >> 9) & 1) << 5)); }
__host__ __device__ __forceinline__ void stage_rc(int b, int& R, int& C) { const int st = b / 1024, sb = b % 1024, swz = sb ^ (((sb >> 9) & 1) << 5); R = (st >> 1) * 16 + swz / 64; C = (st & 1) * 32 + (swz % 64) / 2; }
__host__ __device__ __forceinline__ int perm32(int rho) { const int n = rho >> 4, i = rho & 15; return 8 * (i >> 2) + 4 * n + (i & 3); }

struct Unit { int pm, pn; };
struct Gemm { const bf16_t* A; const bf16_t* Bt; int M, N, K; };

struct StaticOrder {
    int nM, nN, nwg, G, c;
    __host__ __device__ void init(int M, int N, int G_, int c_) { nM = M / BM; nN = N / BM; nwg = nM * nN; G = G_; c = c_; }
    __host__ __device__ bool next(int i, Unit& u) const {
        const long L = (long)i * G + c; if (L >= nwg) return false;
        int wgid = (int)L; { const int q = nwg / NXCD, r = nwg % NXCD, xcd = wgid % NXCD, off = wgid / NXCD; wgid = (xcd < r ? xcd * (q + 1) : r * (q + 1) + (xcd - r) * q) + off; }
        const int nig = WGM * nN, gid = wgid / nig, fm = gid * WGM, gsz = (nM - fm) < WGM ? (nM - fm) : WGM;
        u.pm = fm + ((wgid % nig) % gsz); u.pn = (wgid % nig) / gsz; return true;
    }
    __device__ __forceinline__ void a_ready(const Unit&) const {}
    __device__ __forceinline__ void done(const Unit&) const {}
};

typedef __bf16 bf16x2_cv __attribute__((ext_vector_type(2)));
typedef float f32x2_cv __attribute__((ext_vector_type(2)));
__device__ __forceinline__ unsigned cvt_pk_bf16(float lo, float hi) { const f32x2_cv v = {lo, hi}; return __builtin_bit_cast(unsigned, __builtin_convertvector(v, bf16x2_cv)); }
__device__ __forceinline__ float silu_f(float g) { return g * __builtin_amdgcn_rcpf(1.0f + __expf(-g)); }

struct EpiBf16 {
    static constexpr bool PERM = true, AFTER_DRAIN = false;
    bf16_t* O; int ldc;
    __device__ __forceinline__ void operator()(const f32x4 (&acc)[2][2][4][2], const Unit& u, int wr, int wc, int fr, int fq) const {
        const int row0 = u.pm * BM + wr * 64 + fr, col0 = u.pn * BM + wc * 32 + 8 * fq;
#pragma unroll
        for (int ai = 0; ai < 2; ++ai)
#pragma unroll
            for (int m = 0; m < 4; ++m) { bf16_t* rowp = O + (size_t)(row0 + ai * HALF + m * 16) * ldc + col0;
#pragma unroll
                for (int bj = 0; bj < 2; ++bj) { const f32x4 v0 = acc[ai][bj][m][0], v1 = acc[ai][bj][m][1];
                    u32x4 w; w.x = cvt_pk_bf16(v0[0], v0[1]); w.y = cvt_pk_bf16(v0[2], v0[3]); w.z = cvt_pk_bf16(v1[0], v1[1]); w.w = cvt_pk_bf16(v1[2], v1[3]);
                    *(u32x4*)(rowp + bj * HALF) = w; } }
    }
};
struct EpiSwiglu {
    static constexpr bool PERM = true, AFTER_DRAIN = false;
    bf16_t* O; int ldc;
    __device__ __forceinline__ void operator()(const f32x4 (&acc)[2][2][4][2], const Unit& u, int wr, int wc, int fr, int fq) const {
        const int row0 = u.pm * BM + wr * 64 + fr, col0 = u.pn * HALF + wc * 32 + 8 * fq;
#pragma unroll
        for (int ai = 0; ai < 2; ++ai)
#pragma unroll
            for (int m = 0; m < 4; ++m) { bf16_t* rowp = O + (size_t)(row0 + ai * HALF + m * 16) * ldc + col0;
                const f32x4 g0 = acc[ai][0][m][0], g1 = acc[ai][0][m][1], u0 = acc[ai][1][m][0], u1 = acc[ai][1][m][1];
                u32x4 w; w.x = cvt_pk_bf16(silu_f(g0[0]) * u0[0], silu_f(g0[1]) * u0[1]); w.y = cvt_pk_bf16(silu_f(g0[2]) * u0[2], silu_f(g0[3]) * u0[3]);
                w.z = cvt_pk_bf16(silu_f(g1[0]) * u1[0], silu_f(g1[1]) * u1[1]); w.w = cvt_pk_bf16(silu_f(g1[2]) * u1[2], silu_f(g1[3]) * u1[3]);
                *(u32x4*)rowp = w; }
    }
};

template <bool FINAL> struct EpiResNorm {
    static constexpr bool PERM = false, AFTER_DRAIN = true;
    const float* R; float* C; bf16_t* HB; const float* gain; float* slots; unsigned* cnt;
    __device__ __forceinline__ void fused(f32x4 (&acc)[2][2][4][2], const Unit& u, int wr, int wc, int fr, int fq, PG8_LAS unsigned char* lds, int wid, int lane) const {
        PG8_LAS float* Pt = (PG8_LAS float*)lds;
        PG8_LAS float* Rs = Pt + 1024;
        const int row0 = u.pm * BM + wr * 64 + fr, col0 = u.pn * BM + wc * 32 + 4 * fq, ldc = 2048;
#pragma unroll
        for (int ai = 0; ai < 2; ++ai)
#pragma unroll
            for (int m = 0; m < 4; ++m) { const size_t off = (size_t)(row0 + ai * HALF + m * 16) * ldc + col0; float ss = 0.f;
#pragma unroll
                for (int bj = 0; bj < 2; ++bj)
#pragma unroll
                    for (int n = 0; n < 2; ++n) { const f32x4 r = *(const f32x4*)(R + off + bj * HALF + n * 16); const f32x4 v = r + acc[ai][bj][m][n]; acc[ai][bj][m][n] = v;
                        ss += (v[0] * v[0] + v[1] * v[1]) + (v[2] * v[2] + v[3] * v[3]); }
                ss += __shfl_xor(ss, 16); ss += __shfl_xor(ss, 32);
                if (fq == 0) Pt[(ai * HALF + wr * 64 + m * 16 + fr) * 4 + wc] = ss; }
        __syncthreads();
        const int tid = wid * 64 + lane;
        if (wid < 4) {
            const f32x4 p4 = *(const PG8_LAS f32x4*)(Pt + tid * 4);
            __hip_atomic_store(slots + (size_t)(u.pm * BM + tid) * 8 + u.pn, (p4[0] + p4[1]) + (p4[2] + p4[3]), __ATOMIC_RELAXED, __HIP_MEMORY_SCOPE_AGENT);
            asm volatile("s_waitcnt vmcnt(0)" ::: "memory");
            if (lane == 0) (void)__hip_atomic_fetch_add(cnt + 16 * u.pm, 1u, __ATOMIC_RELAXED, __HIP_MEMORY_SCOPE_AGENT);
        }
        if (wid == 0) {
            unsigned spins = 0;
            while ((unsigned)__builtin_amdgcn_readfirstlane(__hip_atomic_load(cnt + 16 * u.pm, __ATOMIC_RELAXED, __HIP_MEMORY_SCOPE_AGENT)) < 32u) { __builtin_amdgcn_s_sleep(2); if (++spins > (1u << 18)) break; }
            __builtin_amdgcn_fence(__ATOMIC_ACQUIRE, "agent");
            asm volatile("s_waitcnt vmcnt(0)" ::: "memory");
        }
        __syncthreads();
        if (wid < 4) { float t = 0.f;
#pragma unroll
            for (int k = 0; k < 8; ++k) t += __hip_atomic_load(slots + (size_t)(u.pm * BM + tid) * 8 + k, __ATOMIC_RELAXED, __HIP_MEMORY_SCOPE_AGENT);
            Rs[tid] = 1.0f / sqrtf(t * (1.0f / 2048.0f) + 1e-6f); }
        __syncthreads();
        f32x4 gv[2][2];
#pragma unroll
        for (int bj = 0; bj < 2; ++bj)
#pragma unroll
            for (int n = 0; n < 2; ++n) gv[bj][n] = *(const f32x4*)(gain + col0 + bj * HALF + n * 16);
#pragma unroll
        for (int ai = 0; ai < 2; ++ai)
#pragma unroll
            for (int m = 0; m < 4; ++m) { const size_t off = (size_t)(row0 + ai * HALF + m * 16) * ldc + col0; const float rs = Rs[ai * HALF + wr * 64 + m * 16 + fr];
#pragma unroll
                for (int bj = 0; bj < 2; ++bj)
#pragma unroll
                    for (int n = 0; n < 2; ++n) { const f32x4 v = acc[ai][bj][m][n], y = v * rs * gv[bj][n];
                        if (FINAL) { *(f32x4*)(C + off + bj * HALF + n * 16) = y; }
                        else { *(f32x4*)(C + off + bj * HALF + n * 16) = v; u32x2 w; w.x = cvt_pk_bf16(y[0], y[1]); w.y = cvt_pk_bf16(y[2], y[3]); *(u32x2*)(HB + off + bj * HALF + n * 16) = w; } } }
    }
};

template <class Epi, class Sched, bool ALIGN_EPI = false, bool SP2 = false>
__device__ __forceinline__ void gemm_phase(PG8_LAS unsigned char* lds, const Gemm g, const Sched& S, const Epi& E) {
    int tid_ = threadIdx.x; asm volatile("" : "+v"(tid_));
    const int tid = tid_, wid = __builtin_amdgcn_readfirstlane(tid >> 6), lane = tid & 63, wr = wid >> 2, wc = wid & 3, fr = lane & 15, fq = lane >> 4;
    const int K = g.K, nt = K / BK;
    unsigned voffA[2], voffB[2];
#pragma unroll
    for (int i = 0; i < 2; ++i) { int R, C; stage_rc(tid * 16 + i * 8192, R, C); const int Rb = Epi::PERM ? ((R & ~31) + perm32(R & 31)) : R;
        voffA[i] = (unsigned)(R * K + C) * 2u; voffB[i] = (unsigned)(Rb * K + C) * 2u; }
    const size_t kstep = (size_t)(BK * 2);
    const size_t hstep = (size_t)HALF * K * 2;
    const size_t tstep = 2 * hstep;
    const unsigned ldsw = (unsigned)wid * 1024u;
    const int aoff = lds_byte(wr * 64 + fr, fq * 8), boff = lds_byte(wc * 32 + fr, fq * 8);
#define PG8_SA(b, h) (((b) * 2 + (h)) * HTB)
#define PG8_SB(b, h) ((4 + (b) * 2 + (h)) * HTB)
#define PG8_STAGE(bufoff, gbase, voff) do { _Pragma("unroll") for (int _i = 0; _i < 2; ++_i) \
        __builtin_amdgcn_global_load_lds((const unsigned*)((const char*)(gbase) + (voff)[_i]), (PG8_LAS unsigned*)(lds + (bufoff) + ldsw + _i * 8192), 16, 0, 0); } while (0)
#define PG8_LDA(dst, b, h) do { _Pragma("unroll") for (int m = 0; m < 4; ++m) _Pragma("unroll") for (int k = 0; k < 2; ++k) dst[m][k] = *(const PG8_LAS bf16x8*)(lds + PG8_SA(b, h) + aoff + m * 2048 + k * 1024); } while (0)
#define PG8_LDB(dst, b, h) do { _Pragma("unroll") for (int n = 0; n < 2; ++n) _Pragma("unroll") for (int k = 0; k < 2; ++k) dst[n][k] = *(const PG8_LAS bf16x8*)(lds + PG8_SB(b, h) + boff + n * 2048 + k * 1024); } while (0)
#define PG8_MMA(ai, bj, At, Bt) do { __builtin_amdgcn_s_setprio(1); _Pragma("unroll") for (int m = 0; m < 4; ++m) _Pragma("unroll") for (int n = 0; n < 2; ++n) _Pragma("unroll") for (int k = 0; k < 2; ++k) \
        acc[ai][bj][m][n] = __builtin_amdgcn_mfma_f32_16x16x32_bf16(Bt[n][k], At[m][k], acc[ai][bj][m][n], 0, 0, 0); __builtin_amdgcn_s_setprio(0); } while (0)
#define PG8_WAIT_V(n) asm volatile("s_waitcnt vmcnt(" #n ")" ::: "memory")
#define PG8_WAIT_L(n) asm volatile("s_waitcnt lgkmcnt(" #n ")" ::: "memory")
#define PG8_BAR __builtin_amdgcn_s_barrier()
#define PG8_SCHED __builtin_amdgcn_sched_barrier(0)
    Unit cur, nxt; int ui = 0;
    if (!S.next(0, cur)) return;
    f32x4 acc[2][2][4][2];
#pragma unroll
    for (int a = 0; a < 2; ++a)
#pragma unroll
        for (int b = 0; b < 2; ++b)
#pragma unroll
            for (int m = 0; m < 4; ++m)
#pragma unroll
                for (int n = 0; n < 2; ++n) acc[a][b][m][n] = (f32x4){0.f, 0.f, 0.f, 0.f};
    bf16x8 At[4][2], B0[2][2], B1[2][2];
    const char* cA = (const char*)g.A + (size_t)cur.pm * tstep; const char* cB = (const char*)g.Bt + (size_t)cur.pn * tstep;
    S.a_ready(cur);
    if constexpr (SP2) {
        PG8_STAGE(PG8_SB(0, 0), cB, voffB); PG8_STAGE(PG8_SB(0, 1), cB + hstep, voffB); PG8_STAGE(PG8_SA(0, 0), cA, voffA); PG8_STAGE(PG8_SA(0, 1), cA + hstep, voffA);
        if (wr == 1) PG8_BAR;
        PG8_WAIT_V(2); PG8_BAR;
        PG8_STAGE(PG8_SB(1, 0), cB + kstep, voffB); PG8_STAGE(PG8_SA(1, 0), cA + kstep, voffA); PG8_STAGE(PG8_SB(1, 1), cB + hstep + kstep, voffB);
        PG8_WAIT_V(6); PG8_BAR;
    } else {
        PG8_STAGE(PG8_SB(0, 0), cB, voffB); PG8_STAGE(PG8_SA(0, 0), cA, voffA); PG8_STAGE(PG8_SB(0, 1), cB + hstep, voffB); PG8_STAGE(PG8_SA(0, 1), cA + hstep, voffA);
        if (wr == 1) PG8_BAR;
        PG8_WAIT_V(4); PG8_BAR;
        PG8_STAGE(PG8_SB(1, 0), cB + kstep, voffB); PG8_STAGE(PG8_SA(1, 0), cA + kstep, voffA); PG8_STAGE(PG8_SB(1, 1), cB + hstep + kstep, voffB);
        PG8_WAIT_V(6); PG8_BAR;
    }
    for (;;) {
        const bool has_next = S.next(ui + 1, nxt);
        const char* nA = has_next ? (const char*)g.A + (size_t)nxt.pm * tstep : cA; const char* nB = has_next ? (const char*)g.Bt + (size_t)nxt.pn * tstep : cB;
        for (int t = 0; t < nt; t += 2) {
            const bool last = (t == nt - 2);
            const char* a1 = cA + (size_t)(t + 1) * kstep;
            const char* a2 = last ? nA : cA + (size_t)(t + 2) * kstep; const char* b2 = last ? nB : cB + (size_t)(t + 2) * kstep;
            const char* a3 = a2 + kstep; const char* b3 = b2 + kstep;
            if (last && has_next) S.a_ready(nxt);
            if constexpr (SP2) {
            PG8_LDB(B0, 0, 0); PG8_LDB(B1, 0, 1); PG8_SCHED; PG8_LDA(At, 0, 0); PG8_STAGE(PG8_SA(1, 1), a1 + hstep, voffA);
            PG8_WAIT_V(8); PG8_WAIT_L(0); PG8_BAR; PG8_MMA(0, 0, At, B0); PG8_MMA(0, 1, At, B1); PG8_BAR; PG8_SCHED;
            PG8_LDA(At, 0, 1); PG8_STAGE(PG8_SB(0, 0), b2, voffB); PG8_STAGE(PG8_SB(0, 1), b2 + hstep, voffB); PG8_STAGE(PG8_SA(0, 0), a2, voffA);
            PG8_WAIT_V(8); PG8_WAIT_L(0); PG8_BAR; PG8_MMA(1, 0, At, B0); PG8_MMA(1, 1, At, B1); PG8_BAR; PG8_SCHED;
            PG8_LDB(B0, 1, 0); PG8_LDB(B1, 1, 1); PG8_SCHED; PG8_LDA(At, 1, 0); PG8_STAGE(PG8_SA(0, 1), a2 + hstep, voffA);
            PG8_WAIT_V(8); PG8_WAIT_L(0); PG8_BAR; PG8_MMA(0, 0, At, B0); PG8_MMA(0, 1, At, B1); PG8_BAR; PG8_SCHED;
            PG8_LDA(At, 1, 1); PG8_STAGE(PG8_SB(1, 0), b3, voffB); PG8_STAGE(PG8_SB(1, 1), b3 + hstep, voffB); PG8_STAGE(PG8_SA(1, 0), a3, voffA);
            PG8_WAIT_V(8); PG8_WAIT_L(0); PG8_BAR; PG8_MMA(1, 0, At, B0); PG8_MMA(1, 1, At, B1); PG8_BAR; PG8_SCHED;
            } else {
            PG8_LDB(B0, 0, 0); PG8_SCHED; PG8_LDA(At, 0, 0); PG8_STAGE(PG8_SA(1, 1), a1 + hstep, voffA);
            PG8_WAIT_L(8); PG8_BAR; PG8_WAIT_L(0); PG8_MMA(0, 0, At, B0); PG8_BAR; PG8_SCHED;
            PG8_LDB(B1, 0, 1); PG8_STAGE(PG8_SB(0, 0), b2, voffB);
            PG8_BAR; PG8_WAIT_L(0); PG8_MMA(0, 1, At, B1); PG8_BAR;
            PG8_LDA(At, 0, 1); PG8_STAGE(PG8_SA(0, 0), a2, voffA);
            PG8_BAR; PG8_WAIT_L(0); PG8_MMA(1, 0, At, B0); PG8_BAR; PG8_SCHED;
            PG8_STAGE(PG8_SB(0, 1), b2 + hstep, voffB);
            PG8_WAIT_V(6); PG8_BAR; PG8_MMA(1, 1, At, B1); PG8_BAR;
            PG8_LDB(B0, 1, 0); PG8_SCHED; PG8_LDA(At, 1, 0); PG8_STAGE(PG8_SA(0, 1), a2 + hstep, voffA);
            PG8_WAIT_L(8); PG8_BAR; PG8_WAIT_L(0); PG8_MMA(0, 0, At, B0); PG8_BAR; PG8_SCHED;
            PG8_LDB(B1, 1, 1); PG8_STAGE(PG8_SB(1, 0), b3, voffB);
            PG8_BAR; PG8_WAIT_L(0); PG8_MMA(0, 1, At, B1); PG8_BAR;
            PG8_LDA(At, 1, 1); PG8_STAGE(PG8_SA(1, 0), a3, voffA);
            PG8_BAR; PG8_WAIT_L(0); PG8_MMA(1, 0, At, B0); PG8_BAR; PG8_SCHED;
            PG8_STAGE(PG8_SB(1, 1), b3 + hstep, voffB);
            PG8_WAIT_V(6); PG8_BAR; PG8_MMA(1, 1, At, B1); PG8_BAR;
            }
        }
        if constexpr (ALIGN_EPI) { if (wr == 0) PG8_BAR; }
        if constexpr (!Epi::AFTER_DRAIN) { E(acc, cur, wr, wc, fr, fq); S.done(cur); }
        if (!has_next) break;
#pragma unroll
        for (int a = 0; a < 2; ++a)
#pragma unroll
            for (int b = 0; b < 2; ++b)
#pragma unroll
                for (int m = 0; m < 4; ++m)
#pragma unroll
                    for (int n = 0; n < 2; ++n) acc[a][b][m][n] = (f32x4){0.f, 0.f, 0.f, 0.f};
        cur = nxt; cA = nA; cB = nB; ++ui;
        if constexpr (ALIGN_EPI) { if (wr == 1) PG8_BAR; }
    }
    PG8_WAIT_V(0);
    if constexpr (!ALIGN_EPI) { if (wr == 0) PG8_BAR; }
    PG8_BAR;
    if constexpr (Epi::AFTER_DRAIN) { E.fused(acc, cur, wr, wc, fr, fq, lds, wid, lane); S.done(cur); }
#undef PG8_SA
#undef PG8_SB
#undef PG8_STAGE
#undef PG8_LDA
#undef PG8_LDB
#undef PG8_MMA
#undef PG8_WAIT_V
#undef PG8_WAIT_L
#undef PG8_BAR
#undef PG8_SCHED
}
}

#define LAS __attribute__((address_space(3)))
typedef unsigned short bf16_t;
typedef float f32x4 __attribute__((ext_vector_type(4)));
typedef unsigned u32x4 __attribute__((ext_vector_type(4)));
typedef unsigned u32x2 __attribute__((ext_vector_type(2)));
constexpr int DM = 2048, SEQ = 2048, MTOK = 8192, DEPTH = 2;
constexpr int RH = 8, RW = 1024, LW = 1024, INW = 6144, DFF = 5632, NCH = 32;
constexpr float EPS = 1e-6f;
constexpr int NT = 512;
constexpr int LDS_BYTES = 136 * 1024;

constexpr size_t MiB = 1u << 20;
constexpr size_t WS_ROPE = 0;
constexpr size_t WS_WIN = 1 * MiB;
constexpr size_t WS_WOUT = 25 * MiB;
constexpr size_t WS_WGU = 33 * MiB;
constexpr size_t WS_WDN = 77 * MiB;
constexpr size_t WS_P = 99 * MiB;
constexpr size_t WS_U = 195 * MiB;
constexpr size_t WS_MIX = 259 * MiB;
constexpr size_t WS_H = 291 * MiB;
constexpr size_t WS_HL = 323 * MiB;
constexpr size_t WS_ACUM = 355 * MiB;
constexpr size_t WS_APROD = 387 * MiB;
constexpr size_t WS_HEND = 387 * MiB + 512 * 1024;
constexpr size_t WS_BAR = 388 * MiB;
constexpr size_t WS_CARRY = 389 * MiB;
constexpr size_t WS_WAT = 389 * MiB + 512 * 1024;
constexpr size_t WS_SB = 390 * MiB;
constexpr size_t WS_SLOTS = 422 * MiB;
constexpr size_t WS_CNT = 423 * MiB;
constexpr size_t WS_END = 424 * MiB;

__device__ __forceinline__ float bf2f(bf16_t v) { return __uint_as_float((unsigned)v << 16); }
typedef __bf16 bf16x2_hw __attribute__((ext_vector_type(2)));
typedef float f32x2_hw __attribute__((ext_vector_type(2)));
__device__ __forceinline__ unsigned pk2(float lo, float hi) { const f32x2_hw v = {lo, hi}; return __builtin_bit_cast(unsigned, __builtin_convertvector(v, bf16x2_hw)); }
__device__ __forceinline__ unsigned f2bf(float f) { return pk2(f, 0.f) & 0xffffu; }
__device__ __forceinline__ float wave_sum(float v) {
#pragma unroll
    for (int o = 1; o < 64; o <<= 1) v += __shfl_xor(v, o);
    return v;
}
__device__ __forceinline__ float sigmoid_f(float x) { return 1.0f / (1.0f + __expf(-x)); }
__device__ __forceinline__ float gelu_tanh_f(float x) {
    const float u = 0.7978845608028654f * (x + 0.044715f * x * x * x);
    const float t = 1.0f - 2.0f * __builtin_amdgcn_rcpf(1.0f + __expf(2.0f * u));
    return 0.5f * x * (1.0f + t);
}

struct Args { const float* in[18]; float* out; unsigned char* ws; int ph_lo, ph_hi; };

__device__ __forceinline__ void transpose_item(const float* W, int K, int N, bf16_t* WT, int k0, int n0, int dst_row0, LAS float* scr, int lane) {
    const int kk = lane >> 4, n4 = (lane & 15) * 4; f32x4 v[16];
#pragma unroll
    for (int i = 0; i < 16; ++i) v[i] = *(const f32x4*)(W + (size_t)(k0 + kk + 4 * i) * N + n0 + n4);
#pragma unroll
    for (int i = 0; i < 16; ++i) { LAS float* d = scr + (kk + 4 * i) * 65 + n4; d[0] = v[i][0]; d[1] = v[i][1]; d[2] = v[i][2]; d[3] = v[i][3]; }
    asm volatile("s_waitcnt lgkmcnt(0)" ::: "memory");
    const int c = lane & 7;
#pragma unroll
    for (int j = 0; j < 8; ++j) { const int n = (lane >> 3) + 8 * j; const LAS float* s = scr + (8 * c) * 65 + n;
        u32x4 o; o.x = pk2(s[0 * 65], s[1 * 65]); o.y = pk2(s[2 * 65], s[3 * 65]); o.z = pk2(s[4 * 65], s[5 * 65]); o.w = pk2(s[6 * 65], s[7 * 65]);
        *(u32x4*)(WT + (size_t)(dst_row0 + n) * K + k0 + 8 * c) = o; }
    asm volatile("s_waitcnt lgkmcnt(0)" ::: "memory");
}
__device__ __forceinline__ void convert_weights(const Args& a, int l, LAS unsigned char* lds, int gw, int NGW, int wave, int lane, int part) {
    LAS float* scr = (LAS float*)(lds + wave * 16640);
    const float* w_in = a.in[2] + (size_t)l * DM * INW; const float* w_out = a.in[12] + (size_t)l * DM * DM;
    const float* w_g = a.in[14] + (size_t)l * DM * DFF; const float* w_u = a.in[15] + (size_t)l * DM * DFF; const float* w_d = a.in[16] + (size_t)l * DFF * DM;
    bf16_t* WIN = (bf16_t*)(a.ws + WS_WIN); bf16_t* WOUT = (bf16_t*)(a.ws + WS_WOUT); bf16_t* WGU = (bf16_t*)(a.ws + WS_WGU); bf16_t* WDN = (bf16_t*)(a.ws + WS_WDN);
    constexpr int I_IN = (DM / 64) * (INW / 64), I_OUT = (DM / 64) * (DM / 64), I_G = (DM / 64) * (DFF / 64), I_D = (DFF / 64) * (DM / 64);
    constexpr int NITEMS = I_IN + I_OUT + 2 * I_G + I_D;
    const int it_lo = part == 2 ? I_IN + I_OUT : 0, it_hi = part == 1 ? I_IN + I_OUT : NITEMS;
    for (int it = it_lo + gw; it < it_hi; it += NGW) {
        int r = it; const float* W; bf16_t* WT; int K, N, dsel;
        if (r < I_IN) { W = w_in; WT = WIN; K = DM; N = INW; dsel = 0; }
        else if ((r -= I_IN) < I_OUT) { W = w_out; WT = WOUT; K = DM; N = DM; dsel = 0; }
        else if ((r -= I_OUT) < I_G) { W = w_g; WT = WGU; K = DM; N = DFF; dsel = 1; }
        else if ((r -= I_G) < I_G) { W = w_u; WT = WGU; K = DM; N = DFF; dsel = 2; }
        else { r -= I_G; W = w_d; WT = WDN; K = DFF; N = DM; dsel = 0; }
        const int nb = N / 64, kb = r / nb, n0 = (r % nb) * 64;
        const int dst = dsel == 0 ? n0 : (n0 >> 7) * 256 + (n0 & 127) + (dsel == 2 ? 128 : 0);
        transpose_item(W, K, N, WT, kb * 64, n0, dst, scr, lane);
    }
}
template <bool OUT_F32>
__device__ __forceinline__ void rmsnorm_rows(const float* X, const float* g, void* outp, int gw, int NGW, int lane) {
    f32x4 gv[8];
#pragma unroll
    for (int j = 0; j < 8; ++j) gv[j] = *(const f32x4*)(g + j * 256 + lane * 4);
    for (int m = gw; m < MTOK; m += NGW) {
        const float* xr = X + (size_t)m * DM; f32x4 v[8]; float s = 0.f;
#pragma unroll
        for (int j = 0; j < 8; ++j) { v[j] = *(const f32x4*)(xr + j * 256 + lane * 4); s += (v[j][0] * v[j][0] + v[j][1] * v[j][1]) + (v[j][2] * v[j][2] + v[j][3] * v[j][3]); }
        const float rs = 1.0f / sqrtf(wave_sum(s) * (1.0f / DM) + EPS);
        if (OUT_F32) { float* o = (float*)outp + (size_t)m * DM;
#pragma unroll
            for (int j = 0; j < 8; ++j) *(f32x4*)(o + j * 256 + lane * 4) = v[j] * rs * gv[j];
        } else { bf16_t* o = (bf16_t*)outp + (size_t)m * DM;
#pragma unroll
            for (int j = 0; j < 8; ++j) { const f32x4 y = v[j] * rs * gv[j]; u32x2 w; w.x = pk2(y[0], y[1]); w.y = pk2(y[2], y[3]); *(u32x2*)(o + j * 256 + lane * 4) = w; } }
    }
}
__device__ __forceinline__ void rope_table(float2* tab, int gtid, int NG) {
    for (int i = gtid; i < SEQ * 64; i += NG) { const int t = i >> 6, d = i & 63;
        const float inv = 1.0f / powf(10000.0f, (float)d * (1.0f / 64.0f)); const float ang = (float)t * inv;
        const double rev = (double)ang * 0.15915494309189535; const float fr = (float)(rev - floor(rev));
        tab[i] = make_float2(__builtin_amdgcn_cosf(fr), __builtin_amdgcn_sinf(fr)); }
}

typedef short bf16x8_t __attribute__((ext_vector_type(8)));
__device__ __forceinline__ unsigned off_b(unsigned row, unsigned ch) { return 256u * row + 16u * (ch ^ (((row & 3u) << 2) | ((row >> 2) & 3u))); }
typedef short s16x4 __attribute__((ext_vector_type(4)));
__device__ __forceinline__ unsigned tr_addr(unsigned R0, unsigned c, unsigned fr) { const unsigned q = fr >> 2, p = fr & 3; return off_b(R0 + q, 2 * c + (p >> 1)) + 8 * (p & 1); }
#define TR_READ2(d0, d1, a0, a1) asm volatile("ds_read_b64_tr_b16 %0, %2\n\tds_read_b64_tr_b16 %1, %3\n\ts_waitcnt lgkmcnt(0)" : "=&v"(d0), "=&v"(d1) : "v"(a0), "v"(a1) : "memory")
#define TR_READ4(d0, d1, d2, d3, a0, a1, a2, a3) asm volatile("ds_read_b64_tr_b16 %0, %4\n\tds_read_b64_tr_b16 %1, %5\n\tds_read_b64_tr_b16 %2, %6\n\tds_read_b64_tr_b16 %3, %7\n\ts_waitcnt lgkmcnt(0)" \
    : "=&v"(d0), "=&v"(d1), "=&v"(d2), "=&v"(d3) : "v"(a0), "v"(a1), "v"(a2), "v"(a3) : "memory")
template <int CTRL> __device__ __forceinline__ float dppf(float v) { return __int_as_float(__builtin_amdgcn_update_dpp(0, __float_as_int(v), CTRL, 0xf, 0xf, true)); }
__device__ __forceinline__ float row16_sum(float v) { v += dppf<0xB1>(v); v += dppf<0x4E>(v); v += dppf<0x141>(v); v += dppf<0x140>(v); return v; }
__device__ __forceinline__ bf16x8_t cat4(s16x4 a, s16x4 b) { return (bf16x8_t){a[0], a[1], a[2], a[3], b[0], b[1], b[2], b[3]}; }
__device__ __forceinline__ float ret_logg(int h) { return log1pf(-exp2f(-5.0f - (float)h)); }
__device__ __forceinline__ float bflo(unsigned w) { return __uint_as_float(w << 16); }
__device__ __forceinline__ float bfhi(unsigned w) { return __uint_as_float(w & 0xffff0000u); }
__device__ __forceinline__ void rope_apply(const u32x4 lo, const u32x4 hi, const f32x4 (&cs)[4], LAS unsigned char* img, int c, int ch, float scale) {
    float t1[8] = {bflo(lo.x), bfhi(lo.x), bflo(lo.y), bfhi(lo.y), bflo(lo.z), bfhi(lo.z), bflo(lo.w), bfhi(lo.w)};
    float t2[8] = {bflo(hi.x), bfhi(hi.x), bflo(hi.y), bfhi(hi.y), bflo(hi.z), bfhi(hi.z), bflo(hi.w), bfhi(hi.w)};
    float o1[8], o2[8];
#pragma unroll
    for (int k = 0; k < 4; ++k) {
        o1[2 * k] = (t1[2 * k] * cs[k][0] - t2[2 * k] * cs[k][1]) * scale; o2[2 * k] = (t1[2 * k] * cs[k][1] + t2[2 * k] * cs[k][0]) * scale;
        o1[2 * k + 1] = (t1[2 * k + 1] * cs[k][2] - t2[2 * k + 1] * cs[k][3]) * scale; o2[2 * k + 1] = (t1[2 * k + 1] * cs[k][3] + t2[2 * k + 1] * cs[k][2]) * scale; }
    u32x4 w1, w2; w1.x = pk2(o1[0], o1[1]); w1.y = pk2(o1[2], o1[3]); w1.z = pk2(o1[4], o1[5]); w1.w = pk2(o1[6], o1[7]);
    w2.x = pk2(o2[0], o2[1]); w2.y = pk2(o2[2], o2[3]); w2.z = pk2(o2[4], o2[5]); w2.w = pk2(o2[6], o2[7]);
    *(LAS u32x4*)(img + off_b(c, ch)) = w1; *(LAS u32x4*)(img + off_b(c, ch + 8)) = w2;
}
struct R1Regs { u32x4 klo, khi, v[2]; f32x4 cs[4]; };
__device__ __forceinline__ void ret1_load(R1Regs& r, const bf16_t* P, const float2* rope, int item, int tid) {
    const int b = item >> 8, n = (item >> 3) & 31, h = item & 7, row0 = b * SEQ + n * 64, c = tid >> 3, ch = tid & 7;
    const bf16_t* src = P + (size_t)(row0 + c) * INW + 1024 + h * 128; r.klo = *(const u32x4*)(src + 8 * ch); r.khi = *(const u32x4*)(src + 64 + 8 * ch);
    const float2* rp = rope + (n * 64 + c) * 64;
#pragma unroll
    for (int k = 0; k < 4; ++k) r.cs[k] = *(const f32x4*)(rp + 8 * ch + 2 * k);
#pragma unroll
    for (int k = 0; k < 2; ++k) { const int i = tid + NT * k; r.v[k] = *(const u32x4*)(P + (size_t)(row0 + (i >> 4)) * INW + 2048 + h * 128 + 8 * (i & 15)); }
}
__device__ __forceinline__ void ret_stage1_block(const Args& a, LAS unsigned char* lds, int bid, int G, int tid) {
    const bf16_t* P = (const bf16_t*)(a.ws + WS_P); const float2* rope = (const float2*)(a.ws + WS_ROPE); bf16_t* U = (bf16_t*)(a.ws + WS_U);
    LAS unsigned char* Ki = lds; LAS unsigned char* Vi = lds + 16384;
    const int lane = tid & 63, wave = tid >> 6, fr = lane & 15, fq = lane >> 4;
    const unsigned kb = (unsigned)(size_t)Ki, vb = (unsigned)(size_t)Vi;
    R1Regs rg;
    if (bid < 1024) ret1_load(rg, P, rope, bid, tid);
    for (int item = bid; item < 1024; item += G) {
        const int b = item >> 8, n = (item >> 3) & 31, h = item & 7; const float lg = ret_logg(h);
        { const int c = tid >> 3, ch = tid & 7; rope_apply(rg.klo, rg.khi, rg.cs, Ki, c, ch, 0.08838834764831845f * __expf(lg * (float)(63 - c)));
#pragma unroll
          for (int k = 0; k < 2; ++k) { const int i = tid + NT * k; *(LAS u32x4*)(Vi + off_b(i >> 4, i & 15)) = rg.v[k]; } }
        __syncthreads();
        if (item + G < 1024) ret1_load(rg, P, rope, item + G, tid);
        bf16x8_t af[2];
        { s16x4 x0, x1, x2, x3; TR_READ4(x0, x1, x2, x3, kb + tr_addr(8 * fq, wave, fr), kb + tr_addr(8 * fq + 4, wave, fr), kb + tr_addr(32 + 8 * fq, wave, fr), kb + tr_addr(32 + 8 * fq + 4, wave, fr)); af[0] = cat4(x0, x1); af[1] = cat4(x2, x3); }
        bf16_t* up = U + (size_t)((b * 8 + h) * 32 + n) * 16384 + (size_t)(16 * wave + fr) * 128 + 4 * fq;
#pragma unroll
        for (int eb = 0; eb < 8; ++eb) { f32x4 acc = (f32x4){0.f, 0.f, 0.f, 0.f};
            { s16x4 x0, x1, x2, x3; TR_READ4(x0, x1, x2, x3, vb + tr_addr(8 * fq, eb, fr), vb + tr_addr(8 * fq + 4, eb, fr), vb + tr_addr(32 + 8 * fq, eb, fr), vb + tr_addr(32 + 8 * fq + 4, eb, fr));
                acc = __builtin_amdgcn_mfma_f32_16x16x32_bf16(cat4(x0, x1), af[0], acc, 0, 0, 0); acc = __builtin_amdgcn_mfma_f32_16x16x32_bf16(cat4(x2, x3), af[1], acc, 0, 0, 0); }
            u32x2 w; w.x = pk2(acc[0], acc[1]); w.y = pk2(acc[2], acc[3]); *(u32x2*)(up + 16 * eb) = w; }
        __syncthreads();
    }
}
__device__ __forceinline__ void ret_scan(const Args& a, int gtid, int NG) {
    const u32x2* U4 = (const u32x2*)(a.ws + WS_U); u32x2* S2 = (u32x2*)(a.ws + WS_SB);
    for (int i = gtid; i < 32 * 4096; i += NG) { const int bh = i >> 12, q = i & 4095, h = bh & 7; const float dec = __expf(64.0f * ret_logg(h));
        const u32x2* ub = U4 + (size_t)bh * 32 * 4096 + q; u32x2* sb = S2 + (size_t)bh * 32 * 4096 + q; f32x4 s = (f32x4){0.f, 0.f, 0.f, 0.f};
#pragma unroll 8
        for (int n = 0; n < 32; ++n) { const u32x2 ur = ub[(size_t)n * 4096]; const f32x4 u = (f32x4){bflo(ur.x), bfhi(ur.x), bflo(ur.y), bfhi(ur.y)}; u32x2 w; w.x = pk2(s[0], s[1]); w.y = pk2(s[2], s[3]); sb[(size_t)n * 4096] = w; s = s * dec + u; } }
}
struct R3Regs { u32x4 qlo, qhi, klo, khi, v[2], sv[4]; f32x4 cs[4]; };
__device__ __forceinline__ void ret3_load(R3Regs& r, const bf16_t* P, const float2* rope, const bf16_t* SB, int item, int tid) {
    const int b = item >> 8, n = (item >> 3) & 31, h = item & 7, row0 = b * SEQ + n * 64, c = tid >> 3, ch = tid & 7;
    const bf16_t* pr = P + (size_t)(row0 + c) * INW + h * 128;
    r.qlo = *(const u32x4*)(pr + 8 * ch); r.qhi = *(const u32x4*)(pr + 64 + 8 * ch); r.klo = *(const u32x4*)(pr + 1024 + 8 * ch); r.khi = *(const u32x4*)(pr + 1024 + 64 + 8 * ch);
    const float2* rp = rope + (n * 64 + c) * 64;
#pragma unroll
    for (int k = 0; k < 4; ++k) r.cs[k] = *(const f32x4*)(rp + 8 * ch + 2 * k);
#pragma unroll
    for (int k = 0; k < 2; ++k) { const int i = tid + NT * k; const bf16_t* vr = P + (size_t)(row0 + (i >> 4)) * INW + h * 128 + 8 * (i & 15); r.v[k] = *(const u32x4*)(vr + 2048); }
    const bf16_t* sp = SB + (size_t)((b * 8 + h) * 32 + n) * 16384;
#pragma unroll
    for (int k = 0; k < 4; ++k) { const int i = tid + NT * k; r.sv[k] = *(const u32x4*)(sp + (size_t)(i >> 4) * 128 + 8 * (i & 15)); }
}
__device__ __forceinline__ void ret_stage3_block(const Args& a, int l, LAS unsigned char* lds, int bid, int G, int tid) {
    const bf16_t* P = (const bf16_t*)(a.ws + WS_P); const float2* rope = (const float2*)(a.ws + WS_ROPE); const bf16_t* SB = (const bf16_t*)(a.ws + WS_SB);
    bf16_t* MIX = (bf16_t*)(a.ws + WS_MIX); const float* gn_g = a.in[3] + l * RW;
    LAS unsigned char* Qi = lds; LAS unsigned char* Ki = lds + 16384; LAS unsigned char* Vi = lds + 32768; LAS unsigned char* Si = lds + 49152; LAS float* part = (LAS float*)(lds + 81920);
    const int lane = tid & 63, wave = tid >> 6, fr = lane & 15, fq = lane >> 4;
    R3Regs rg;
    if (bid < 1024) ret3_load(rg, P, rope, SB, bid, tid);
  for (int item = bid; item < 1024; item += G) {
    const int b = item >> 8, n = (item >> 3) & 31, h = item & 7, row0 = b * SEQ + n * 64; const float lg = ret_logg(h);
    { const int c = tid >> 3, ch = tid & 7; rope_apply(rg.qlo, rg.qhi, rg.cs, Qi, c, ch, 1.0f); rope_apply(rg.klo, rg.khi, rg.cs, Ki, c, ch, 0.08838834764831845f);
#pragma unroll
      for (int k = 0; k < 2; ++k) { const int i = tid + NT * k; *(LAS u32x4*)(Vi + off_b(i >> 4, i & 15)) = rg.v[k]; }
#pragma unroll
      for (int k = 0; k < 4; ++k) { const int i = tid + NT * k; *(LAS u32x4*)(Si + off_b(i >> 4, i & 15)) = rg.sv[k]; } }
    __syncthreads();
    u32x4 gpre[2];
#pragma unroll
    for (int k = 0; k < 2; ++k) { const int i = tid + NT * k; gpre[k] = *(const u32x4*)(P + (size_t)(row0 + (i >> 4)) * INW + 3072 + h * 128 + 8 * (i & 15)); }
    if (item + G < 1024) ret3_load(rg, P, rope, SB, item + G, tid);
    const int ab = wave & 3, eh = wave >> 2;
    const unsigned vb = (unsigned)(size_t)Vi, sbs = (unsigned)(size_t)Si;
    bf16x8_t qf[4];
#pragma unroll
    for (int ks = 0; ks < 4; ++ks) qf[ks] = *(const LAS bf16x8_t*)(Qi + off_b(16 * ab + fr, 4 * ks + fq));
    unsigned sp[4][2];
#pragma unroll
    for (int cb = 0; cb < 4; ++cb) { f32x4 acc = (f32x4){0.f, 0.f, 0.f, 0.f};
#pragma unroll
        for (int ks = 0; ks < 4; ++ks) { const bf16x8_t kf = *(const LAS bf16x8_t*)(Ki + off_b(16 * cb + fr, 4 * ks + fq)); acc = __builtin_amdgcn_mfma_f32_16x16x32_bf16(kf, qf[ks], acc, 0, 0, 0); }
        float d[4];
#pragma unroll
        for (int r = 0; r < 4; ++r) d[r] = acc[r] * __expf(lg * fabsf((float)(16 * ab + fr - (16 * cb + 4 * fq + r))));
        sp[cb][0] = pk2(d[0], d[1]); sp[cb][1] = pk2(d[2], d[3]); }
    f32x4 oi[4], oc[4];
#pragma unroll
    for (int e = 0; e < 4; ++e) { const int eb = 4 * eh + e; oi[e] = (f32x4){0.f, 0.f, 0.f, 0.f}; oc[e] = (f32x4){0.f, 0.f, 0.f, 0.f};
        {
            s16x4 x0, x1, x2, x3; TR_READ4(x0, x1, x2, x3, vb + tr_addr(4 * fq, eb, fr), vb + tr_addr(16 + 4 * fq, eb, fr), vb + tr_addr(32 + 4 * fq, eb, fr), vb + tr_addr(48 + 4 * fq, eb, fr));
            u32x4 aw; aw.x = sp[0][0]; aw.y = sp[0][1]; aw.z = sp[1][0]; aw.w = sp[1][1];
            oi[e] = __builtin_amdgcn_mfma_f32_16x16x32_bf16(__builtin_bit_cast(bf16x8_t, aw), cat4(x0, x1), oi[e], 0, 0, 0);
            aw.x = sp[2][0]; aw.y = sp[2][1]; aw.z = sp[3][0]; aw.w = sp[3][1];
            oi[e] = __builtin_amdgcn_mfma_f32_16x16x32_bf16(__builtin_bit_cast(bf16x8_t, aw), cat4(x2, x3), oi[e], 0, 0, 0); }
#pragma unroll
        for (int kp = 0; kp < 2; ++kp) { s16x4 x0, x1, x2, x3;
            TR_READ4(x0, x1, x2, x3, sbs + tr_addr(64 * kp + 8 * fq, eb, fr), sbs + tr_addr(64 * kp + 8 * fq + 4, eb, fr), sbs + tr_addr(64 * kp + 32 + 8 * fq, eb, fr), sbs + tr_addr(64 * kp + 32 + 8 * fq + 4, eb, fr));
            oc[e] = __builtin_amdgcn_mfma_f32_16x16x32_bf16(qf[2 * kp], cat4(x0, x1), oc[e], 0, 0, 0);
            oc[e] = __builtin_amdgcn_mfma_f32_16x16x32_bf16(qf[2 * kp + 1], cat4(x2, x3), oc[e], 0, 0, 0); } }
    float s1[4], s2[4];
#pragma unroll
    for (int r = 0; r < 4; ++r) { const float qd = __expf(lg * (float)(16 * ab + 4 * fq + r + 1)); s1[r] = 0.f; s2[r] = 0.f;
#pragma unroll
        for (int e = 0; e < 4; ++e) { const float v = oi[e][r] + qd * oc[e][r]; oi[e][r] = v; s1[r] += v; s2[r] += v * v; } }
#pragma unroll
    for (int r = 0; r < 4; ++r) { s1[r] = row16_sum(s1[r]); s2[r] = row16_sum(s2[r]);
        if (fr == 0) { part[(eh * 64 + 16 * ab + 4 * fq + r) * 2] = s1[r]; part[(eh * 64 + 16 * ab + 4 * fq + r) * 2 + 1] = s2[r]; } }
    __syncthreads();
    LAS bf16_t* Y = (LAS bf16_t*)lds;
    float gnv[4];
#pragma unroll
    for (int e = 0; e < 4; ++e) gnv[e] = gn_g[h * 128 + 16 * (4 * eh + e) + fr];
#pragma unroll
    for (int r = 0; r < 4; ++r) { const int aa = 16 * ab + 4 * fq + r;
        const float t1 = part[aa * 2] + part[(64 + aa) * 2], t2 = part[aa * 2 + 1] + part[(64 + aa) * 2 + 1];
        const float mu = t1 * (1.0f / 128.0f), var = fmaxf(t2 * (1.0f / 128.0f) - mu * mu, 0.f), rstd = __builtin_amdgcn_rsqf(var + EPS);
#pragma unroll
        for (int e = 0; e < 4; ++e) Y[aa * 136 + 16 * (4 * eh + e) + fr] = (bf16_t)f2bf((oi[e][r] - mu) * rstd * gnv[e]); }
    __syncthreads();
#pragma unroll
    for (int k = 0; k < 2; ++k) { const int c = tid + NT * k, row = c >> 4, ch = c & 15;
        const u32x4 yv = *(const LAS u32x4*)(Y + row * 136 + 8 * ch); const u32x4 gv = gpre[k]; u32x4 w;
        w.x = pk2(bflo(yv.x) * pg8::silu_f(bflo(gv.x)), bfhi(yv.x) * pg8::silu_f(bfhi(gv.x))); w.y = pk2(bflo(yv.y) * pg8::silu_f(bflo(gv.y)), bfhi(yv.y) * pg8::silu_f(bfhi(gv.y)));
        w.z = pk2(bflo(yv.z) * pg8::silu_f(bflo(gv.z)), bfhi(yv.z) * pg8::silu_f(bfhi(gv.z))); w.w = pk2(bflo(yv.w) * pg8::silu_f(bflo(gv.w)), bfhi(yv.w) * pg8::silu_f(bfhi(gv.w)));
        *(u32x4*)(MIX + (size_t)(row0 + row) * DM + h * 128 + 8 * ch) = w; }
    __syncthreads();
  }
}

__device__ __forceinline__ void lru_gate_weights(const Args& a, int gtid, int NG) {
    bf16_t* WAT = (bf16_t*)(a.ws + WS_WAT);
    for (int idx = gtid; idx < 2 * 16 * 2 * 4096; idx += NG) { const int i = idx & 63, j = (idx >> 6) & 63, gate = (idx >> 12) & 1, lg = idx >> 13;
        const float* w = (gate ? a.in[8] : a.in[6]) + (size_t)lg * 4096; WAT[idx] = (bf16_t)f2bf(w[i * 64 + j]); }
}
constexpr int XBS = 72;
__device__ __forceinline__ void lru_stage1_block(const Args& a, int l, LAS unsigned char* lds, int bid, int G, int tid) {
    const bf16_t* P = (const bf16_t*)(a.ws + WS_P);
    bf16_t* HL = (bf16_t*)(a.ws + WS_HL); bf16_t* ACUM = (bf16_t*)(a.ws + WS_ACUM); float* APROD = (float*)(a.ws + WS_APROD); float* HEND = (float*)(a.ws + WS_HEND);
    const float* conv_w = a.in[4] + l * 4 * LW; const float* conv_b = a.in[5] + l * LW; const float* ba = a.in[7] + l * LW; const float* bx = a.in[9] + l * LW; const float* lam = a.in[10] + l * LW;
    const bf16_t* WAT = (const bf16_t*)(a.ws + WS_WAT) + (size_t)l * 16 * 2 * 4096;
    LAS bf16_t* XB = (LAS bf16_t*)lds;
    LAS bf16_t* WT = XB + 64 * XBS;
    LAS float* XF = (LAS float*)(WT + 2 * 64 * XBS);
    LAS float* As = XF + 64 * 65; LAS float* Bs = As + 64 * 65; LAS float* segP = Bs + 64 * 65; LAS float* segH = segP + 512;
    const int lane = tid & 63, wave = tid >> 6, fr = lane & 15, fq = lane >> 4;
    const int per = (2048 + G - 1) / G; const int it_end = (bid + 1) * per < 2048 ? (bid + 1) * per : 2048;
    int gl = -1, gc = -1; float spv[2] = {0.f, 0.f}, bav[2] = {0.f, 0.f}, bxv[2] = {0.f, 0.f};
    const int j4 = (tid & 15) * 4;
    u32x2 xr[2][4];
#define LRU_LOADX(IT) do { const int bn_ = (IT) & 127, b_ = bn_ >> 5, n_ = bn_ & 31, c0_ = ((IT) >> 7) * 64; \
        _Pragma("unroll") for (int k = 0; k < 2; ++k) _Pragma("unroll") for (int q = 0; q < 4; ++q) { const int tt = n_ * 64 + (tid >> 4) + 32 * k + q - 3; \
            xr[k][q] = tt >= 0 ? *(const u32x2*)(P + (size_t)(b_ * SEQ + tt) * INW + 4096 + c0_ + j4) : (u32x2){0u, 0u}; } } while (0)
    if (bid * per < it_end) LRU_LOADX(bid * per);
    for (int it = bid * per; it < it_end; ++it) {
        const int g = it >> 7, bn = it & 127, b = bn >> 5, n = bn & 31, row0 = b * SEQ + n * 64, ch0 = g * 64;
        if (g != gl) { gl = g;
#pragma unroll
            for (int k = 0; k < 2; ++k) { const int c = tid + NT * k, gate = c >> 9, jr = (c >> 3) & 63, ic = (c & 7) * 8;
                *(LAS u32x4*)(WT + (gate * 64 + jr) * XBS + ic) = *(const u32x4*)(WAT + ((size_t)(g * 2 + gate) * 64 + jr) * 64 + ic); } }
        {
            f32x4 cw[4];
#pragma unroll
            for (int q = 0; q < 4; ++q) cw[q] = *(const f32x4*)(conv_w + q * LW + ch0 + j4);
            const f32x4 cb = *(const f32x4*)(conv_b + ch0 + j4);
#pragma unroll
            for (int k = 0; k < 2; ++k) { const int t = (tid >> 4) + 32 * k; f32x4 v = cb;
#pragma unroll
                for (int q = 0; q < 4; ++q) { const u32x2 r = xr[k][q];
                    v[0] += cw[q][0] * __uint_as_float(r.x << 16); v[1] += cw[q][1] * __uint_as_float(r.x & 0xffff0000u); v[2] += cw[q][2] * __uint_as_float(r.y << 16); v[3] += cw[q][3] * __uint_as_float(r.y & 0xffff0000u); }
                XF[t * 65 + j4] = v[0]; XF[t * 65 + j4 + 1] = v[1]; XF[t * 65 + j4 + 2] = v[2]; XF[t * 65 + j4 + 3] = v[3];
                u32x2 w; w.x = pk2(v[0], v[1]); w.y = pk2(v[2], v[3]); *(LAS u32x2*)(XB + t * XBS + j4) = w; }
        }
        if (it + 1 < it_end) LRU_LOADX(it + 1);
        __syncthreads();
        {
            const int tb = wave & 3, jp = wave >> 2; f32x4 acc[2][2];
#pragma unroll
            for (int ga = 0; ga < 2; ++ga)
#pragma unroll
                for (int jj = 0; jj < 2; ++jj) acc[ga][jj] = (f32x4){0.f, 0.f, 0.f, 0.f};
#pragma unroll
            for (int ks = 0; ks < 2; ++ks) { const bf16x8_t af = *(const LAS bf16x8_t*)(XB + (16 * tb + fr) * XBS + ks * 32 + 8 * fq);
#pragma unroll
                for (int ga = 0; ga < 2; ++ga)
#pragma unroll
                    for (int jj = 0; jj < 2; ++jj) { const bf16x8_t bfr = *(const LAS bf16x8_t*)(WT + (ga * 64 + 16 * (2 * jp + jj) + fr) * XBS + ks * 32 + 8 * fq);
                        acc[ga][jj] = __builtin_amdgcn_mfma_f32_16x16x32_bf16(af, bfr, acc[ga][jj], 0, 0, 0); } }
#pragma unroll
            for (int jj = 0; jj < 2; ++jj) { const int j = 16 * (2 * jp + jj) + fr;
                if (g != gc) { spv[jj] = -8.0f * log1pf(__expf(-lam[ch0 + j])); bav[jj] = ba[ch0 + j]; bxv[jj] = bx[ch0 + j]; }
#pragma unroll
                for (int r = 0; r < 4; ++r) { const int t = 16 * tb + 4 * fq + r;
                    const float rg = __builtin_amdgcn_rcpf(1.0f + __expf(-(acc[0][jj][r] + bav[jj]))), ig = __builtin_amdgcn_rcpf(1.0f + __expf(-(acc[1][jj][r] + bxv[jj])));
                    const float av = __expf(rg * spv[jj]);
                    As[t * 65 + j] = av; Bs[t * 65 + j] = sqrtf(fmaxf(1.0f - av * av, 0.f)) * (ig * XF[t * 65 + j]); } }
            gc = g;
        }
        __syncthreads();
        {
            const int sg = wave, j = lane; float av[8], bv[8];
#pragma unroll
            for (int k = 0; k < 8; ++k) { av[k] = As[(8 * sg + k) * 65 + j]; bv[k] = Bs[(8 * sg + k) * 65 + j]; }
            float pp = 1.f, hh = 0.f;
#pragma unroll
            for (int k = 0; k < 8; ++k) { hh = av[k] * hh + bv[k]; pp *= av[k]; }
            segP[sg * 64 + j] = pp; segH[sg * 64 + j] = hh;
            __syncthreads();
            float hc = 0.f, pc = 1.f;
#pragma unroll
            for (int q = 0; q < 7; ++q) { const float p2 = segP[q * 64 + j], h2 = segH[q * 64 + j]; if (q < sg) { hc = p2 * hc + h2; pc *= p2; } }
#pragma unroll
            for (int k = 0; k < 8; ++k) { hc = av[k] * hc + bv[k]; pc *= av[k]; const size_t o = (size_t)(row0 + 8 * sg + k) * LW + ch0 + j; HL[o] = (bf16_t)f2bf(hc); ACUM[o] = (bf16_t)f2bf(pc); }
            if (sg == 7) { APROD[(b * 32 + n) * LW + ch0 + j] = pc; HEND[(b * 32 + n) * LW + ch0 + j] = hc; }
        }
    }
    __syncthreads();
#undef LRU_LOADX
}
__device__ __forceinline__ void lru_carry_scan(const Args& a, int gtid) {
    const float* APROD = (const float*)(a.ws + WS_APROD); const float* HEND = (const float*)(a.ws + WS_HEND); float* CARRY = (float*)(a.ws + WS_CARRY);
    if (gtid < 4 * LW) { const int b = gtid >> 10, ch = gtid & 1023; float c = 0.f;
        float av[32], hv[32];
#pragma unroll
        for (int n = 0; n < 32; ++n) { const int o = (b * 32 + n) * LW + ch; av[n] = APROD[o]; hv[n] = HEND[o]; }
#pragma unroll
        for (int n = 0; n < 32; ++n) { CARRY[(b * 32 + n) * LW + ch] = c; c = av[n] * c + hv[n]; } }
}
__device__ __forceinline__ void lru_stage3(const Args& a, int l, int gw, int NGW, int lane) {
    const bf16_t* P = (const bf16_t*)(a.ws + WS_P); bf16_t* MIX = (bf16_t*)(a.ws + WS_MIX);
    const bf16_t* HL = (const bf16_t*)(a.ws + WS_HL); const bf16_t* ACUM = (const bf16_t*)(a.ws + WS_ACUM); const float* CARRY = (const float*)(a.ws + WS_CARRY);
    const float* norm_g = a.in[11] + l * LW;
    for (int tb = gw; tb < MTOK; tb += 4 * NGW) {
        f32x4 y[4][4]; float ss[4];
#pragma unroll
        for (int u = 0; u < 4; ++u) { const int t = (tb + u * NGW < MTOK) ? tb + u * NGW : tb, b = t >> 11, n = (t >> 6) & 31; ss[u] = 0.f;
#pragma unroll
            for (int k = 0; k < 4; ++k) { const int ch = k * 256 + lane * 4;
                const u32x2 hr = *(const u32x2*)(HL + (size_t)t * LW + ch), ar = *(const u32x2*)(ACUM + (size_t)t * LW + ch); const f32x4 cr = *(const f32x4*)(CARRY + (b * 32 + n) * LW + ch);
                const f32x4 hl = (f32x4){bflo(hr.x), bfhi(hr.x), bflo(hr.y), bfhi(hr.y)}, ac = (f32x4){bflo(ar.x), bfhi(ar.x), bflo(ar.y), bfhi(ar.y)};
                const u32x2 yr = *(const u32x2*)(P + (size_t)t * INW + 5120 + ch);
                const f32x4 hv = hl + ac * cr;
                y[u][k][0] = hv[0] * gelu_tanh_f(bflo(yr.x)); y[u][k][1] = hv[1] * gelu_tanh_f(bfhi(yr.x)); y[u][k][2] = hv[2] * gelu_tanh_f(bflo(yr.y)); y[u][k][3] = hv[3] * gelu_tanh_f(bfhi(yr.y));
                ss[u] += (y[u][k][0] * y[u][k][0] + y[u][k][1] * y[u][k][1]) + (y[u][k][2] * y[u][k][2] + y[u][k][3] * y[u][k][3]); } }
#pragma unroll
        for (int u = 0; u < 4; ++u) { const int t = (tb + u * NGW < MTOK) ? tb + u * NGW : tb; const float rs = __builtin_amdgcn_rsqf(wave_sum(ss[u]) * (1.0f / LW) + EPS);
#pragma unroll
            for (int k = 0; k < 4; ++k) { const int ch = k * 256 + lane * 4; const f32x4 gv = *(const f32x4*)(norm_g + ch); const f32x4 z = y[u][k] * rs * gv;
                u32x2 w; w.x = pk2(z[0], z[1]); w.y = pk2(z[2], z[3]); *(u32x2*)(MIX + (size_t)t * DM + 1024 + ch) = w; } } }
}

#define XB_TMO      128
#define XB_XCNT(j)  (256  + 64 * (j))
#define XB_XSUB(j)  (1280 + 64 * (j))
#define XB_XGEN(j)  (2304 + 64 * (j))
#define XB_TOP      3328
#define XB_TOPGEN   3392
#define XCD_BAR_WORDS 3456
#define XB_SPIN_CAP (1u << 18)

__device__ __forceinline__ unsigned xb_ld(unsigned* p)              { return __hip_atomic_load(p, __ATOMIC_RELAXED, __HIP_MEMORY_SCOPE_AGENT); }
__device__ __forceinline__ unsigned xb_add(unsigned* p, unsigned v) { return __hip_atomic_fetch_add(p, v, __ATOMIC_RELAXED, __HIP_MEMORY_SCOPE_AGENT); }
__device__ __forceinline__ unsigned xb_xcc_id() { return (unsigned)__builtin_amdgcn_s_getreg((3 << 11) | 20) & 0xFu; }
#define XB_SPIN(cond, bar) do { unsigned _sp = 0; while (cond) { __builtin_amdgcn_s_sleep(1); \
    if ((++_sp & 255u) == 0u) { if (xb_ld(&(bar)[XB_TMO])) break; if (_sp > XB_SPIN_CAP) { atomicAdd(&(bar)[XB_TMO], 1u); break; } } } } while (0)

struct XcdBarrier {
    unsigned* bar; unsigned x;
    volatile LAS unsigned* st;
};

__device__ __forceinline__ XcdBarrier xcd_barrier_post(unsigned* bar, volatile LAS unsigned* st) {
    XcdBarrier b; b.bar = bar; b.x = xb_xcc_id(); b.st = st;
    if (threadIdx.x == 0) (void)xb_add(&bar[XB_XCNT(b.x)], 1u);
    return b;
}
__device__ __forceinline__ void xcd_barrier_complete(unsigned* bar, unsigned x, unsigned& nloc, unsigned& nx) {
    const unsigned G = gridDim.x * gridDim.y * gridDim.z;
    unsigned sum, cnt, mine, sp = 0u;
    for (;;) {
        sum = 0u; cnt = 0u; mine = 0u;
#pragma unroll
        for (unsigned j = 0; j < 16; ++j) { const unsigned c = xb_ld(&bar[XB_XCNT(j)]); sum += c; cnt += (c > 0u) ? 1u : 0u; mine = (j == x) ? c : mine; }
        if (sum == G) break;
        __builtin_amdgcn_s_sleep(1);
        if ((++sp & 255u) == 0u) { if (xb_ld(&bar[XB_TMO])) break; if (sp > XB_SPIN_CAP) { atomicAdd(&bar[XB_TMO], 1u); break; } }
    }
    nloc = mine > 0u ? mine : 1u; nx = cnt > 0u ? cnt : 1u;
}

__device__ __forceinline__ void xcd_barrier(const XcdBarrier& b) {
    asm volatile("s_waitcnt vmcnt(0)" ::: "memory");
    __syncthreads();
    if (threadIdx.x == 0) {
        unsigned* bar = b.bar;
        __builtin_amdgcn_s_waitcnt(0);
        unsigned nloc = b.st[0], nx = b.st[1];
        if (nloc == 0u) { xcd_barrier_complete(bar, b.x, nloc, nx); b.st[0] = nloc; b.st[1] = nx; }
        const unsigned old = xb_add(&bar[XB_XSUB(b.x)], 1u);
        const unsigned gen = old / nloc;
        if (old + 1u == (gen + 1u) * nloc) {
            __builtin_amdgcn_fence(__ATOMIC_RELEASE, "agent");
            asm volatile("s_waitcnt vmcnt(0)" ::: "memory");
            const unsigned og = xb_add(&bar[XB_TOP], 1u);
            const unsigned tg = og / nx;
            if (og + 1u == (tg + 1u) * nx) xb_add(&bar[XB_TOPGEN], 1u);
            else XB_SPIN(xb_ld(&bar[XB_TOPGEN]) == tg, bar);
            __builtin_amdgcn_fence(__ATOMIC_ACQUIRE, "agent");
            xb_add(&bar[XB_XGEN(b.x)], 1u);
            asm volatile("s_waitcnt vmcnt(0)" ::: "memory");
        } else {
            XB_SPIN(xb_ld(&bar[XB_XGEN(b.x)]) == gen, bar);
            __builtin_amdgcn_fence(__ATOMIC_ACQUIRE, "agent");
            asm volatile("s_waitcnt vmcnt(0)" ::: "memory");
        }
    }
    __syncthreads();
}


constexpr int NPHASE = 16;
template <bool COOP>
__global__ void __launch_bounds__(NT, 2) hybrid_fwd(Args a) {
    extern __shared__ __attribute__((aligned(16))) unsigned char lds_raw[];
    LAS unsigned char* lds = (LAS unsigned char*)lds_raw;
    const int bid = blockIdx.x;
    bf16_t* WIN = (bf16_t*)(a.ws + WS_WIN); bf16_t* WOUT = (bf16_t*)(a.ws + WS_WOUT); bf16_t* WGU = (bf16_t*)(a.ws + WS_WGU); bf16_t* WDN = (bf16_t*)(a.ws + WS_WDN);
    bf16_t* PB = (bf16_t*)(a.ws + WS_P); bf16_t* MIX = (bf16_t*)(a.ws + WS_MIX); bf16_t* HB = (bf16_t*)(a.ws + WS_H);
    const unsigned long long pc0 = (unsigned long long)__builtin_amdgcn_s_getpc() & ~0xFFFull;
    const float* x_in = a.in[0]; float* XR = a.out; float* SLOTS = (float*)(a.ws + WS_SLOTS); unsigned* CNT = (unsigned*)(a.ws + WS_CNT);
    XcdBarrier xb; xb.bar = (unsigned*)(a.ws + WS_BAR); xb.x = 0; xb.st = nullptr;
    {
        volatile LAS unsigned* st = (volatile LAS unsigned*)(lds + LDS_BYTES - 16);
        if (threadIdx.x < 4) st[threadIdx.x] = 0u;
        if (a.ph_lo == 0 && bid == 0) {
            for (int i = threadIdx.x; i < XCD_BAR_WORDS; i += NT) ((unsigned*)(a.ws + WS_BAR))[i] = 0u;
            for (int i = threadIdx.x; i < 4 * 512; i += NT) ((unsigned*)(a.ws + WS_CNT))[i] = 0u; }
        __syncthreads();
    }
    for (int ph = a.ph_lo; ph < a.ph_hi; ++ph) {
        const int l = (ph - 1) / 8, sp = (ph == 0) ? -1 : (ph - 1) % 8;
        int tid_ = threadIdx.x; asm volatile("" : "+v"(tid_));
        int G_ = gridDim.x; asm volatile("" : "+s"(G_)); const int G = G_, NGW = G * 8, NG = G * NT;
        const int tid = tid_, lane = tid & 63, wave = __builtin_amdgcn_readfirstlane(tid >> 6), gw = bid * 8 + wave, gtid = bid * NT + tid;
        if (wave < 4) __builtin_amdgcn_global_load_lds((const unsigned*)(pc0 + (unsigned long long)(((bid >> 3) & 31) * 4096 + wave * 1024 + lane * 16)), (LAS unsigned*)(lds + 134144), 16, 0, 0);
        if (ph == 0) {
            convert_weights(a, 0, lds, wave * G + bid, NGW, wave, lane, 0);
            rope_table((float2*)(a.ws + WS_ROPE), gtid, NG);
            lru_gate_weights(a, gtid, NG);
            rmsnorm_rows<false>(x_in, a.in[1], HB, gw, NGW, lane);
        } else if (sp == 0) {
            pg8::Gemm g{HB, WIN, MTOK, INW, DM}; pg8::StaticOrder S; S.init(MTOK, INW, G, bid); pg8::EpiBf16 E{PB, INW};
            pg8::gemm_phase<pg8::EpiBf16, pg8::StaticOrder, true, true>(lds, g, S, E);
        } else if (sp == 1) {
            ret_stage1_block(a, lds, bid, G, tid);
            lru_stage1_block(a, l, lds, bid, G, tid);
        } else if (sp == 2) {
            lru_carry_scan(a, gtid);
            ret_scan(a, gtid, NG);
        } else if (sp == 3) {
            ret_stage3_block(a, l, lds, bid, G, tid);
            lru_stage3(a, l, gw, NGW, lane);
        } else if (sp == 4) {
            pg8::Gemm g{MIX, WOUT, MTOK, DM, DM}; pg8::StaticOrder S; S.init(MTOK, DM, G, bid);
            pg8::EpiResNorm<false> E{l == 0 ? x_in : XR, XR, HB, a.in[13] + l * DM, SLOTS + (size_t)(2 * l) * MTOK * 8, CNT + (2 * l) * 512};
            pg8::gemm_phase<pg8::EpiResNorm<false>, pg8::StaticOrder, true, true>(lds, g, S, E);
        } else if (sp == 5) {
            pg8::Gemm g{HB, WGU, MTOK, 2 * DFF, DM}; pg8::StaticOrder S; S.init(MTOK, 2 * DFF, G, bid); pg8::EpiSwiglu E{PB, DFF};
            pg8::gemm_phase<pg8::EpiSwiglu, pg8::StaticOrder, true, true>(lds, g, S, E);
            if (l == 0) { const int nt_all = (MTOK / 256) * (2 * DFF / 256), rem = nt_all % G;
                if (rem != 0 && bid >= rem) { __syncthreads(); convert_weights(a, 1, lds, wave * (G - rem) + (bid - rem), (G - rem) * 8, wave, lane, 1); }
                else if (rem == 0) { __syncthreads(); convert_weights(a, 1, lds, gw, NGW, wave, lane, 1); } }
        } else if (sp == 6) {
            pg8::Gemm g{PB, WDN, MTOK, DM, DFF}; pg8::StaticOrder S; S.init(MTOK, DM, G, bid);
            if (l == 0) { pg8::EpiResNorm<false> E{XR, XR, HB, a.in[1] + DM, SLOTS + (size_t)MTOK * 8, CNT + 512}; pg8::gemm_phase<pg8::EpiResNorm<false>, pg8::StaticOrder, true, true>(lds, g, S, E); }
            else { pg8::EpiResNorm<true> E{XR, XR, HB, a.in[17], SLOTS + (size_t)3 * MTOK * 8, CNT + 3 * 512}; pg8::gemm_phase<pg8::EpiResNorm<true>, pg8::StaticOrder, true, true>(lds, g, S, E); }
        } else {
            convert_weights(a, 1, lds, wave * G + bid, NGW, wave, lane, 2);
        }
        if (COOP) { if (ph + 1 < a.ph_hi) { if (ph == 0) { cg::this_grid().sync(); xb = xcd_barrier_post((unsigned*)(a.ws + WS_BAR), (volatile LAS unsigned*)(lds + LDS_BYTES - 16)); } else xcd_barrier(xb); } }
        else __syncthreads();
    }
}

extern "C" void kernel_launch(void* const* d_in, const int* in_sizes, int n_in, void* d_out, int out_size, void* d_ws, size_t ws_size, hipStream_t stream) {
    static int grid = 0;
    if (grid == 0) {
        if (n_in != 18 || out_size != MTOK * DM || ws_size < WS_END) { fprintf(stderr, "kernel_launch: unexpected shapes (n_in %d out %d ws %zu)\n", n_in, out_size, ws_size); grid = -1; return; }
        int dev = 0, cus = 0, per_cu = 0;
        hipGetDevice(&dev); hipDeviceGetAttribute(&cus, hipDeviceAttributeMultiprocessorCount, dev);
        hipFuncSetAttribute((const void*)hybrid_fwd<true>, hipFuncAttributeMaxDynamicSharedMemorySize, LDS_BYTES);
        hipFuncSetAttribute((const void*)hybrid_fwd<false>, hipFuncAttributeMaxDynamicSharedMemorySize, LDS_BYTES);
        hipOccupancyMaxActiveBlocksPerMultiprocessor(&per_cu, (const void*)hybrid_fwd<true>, NT, LDS_BYTES);
        if (per_cu < 1) { fprintf(stderr, "kernel_launch: occupancy query says %d blocks per CU\n", per_cu); per_cu = 1; }
        (void)hipGetLastError();
        grid = cus * 1;
    }
    if (grid < 0) return;
    Args a{};
    for (int i = 0; i < 18; ++i) a.in[i] = (const float*)d_in[i];
    a.out = (float*)d_out; a.ws = (unsigned char*)d_ws;
#if MEGA
    a.ph_lo = 0; a.ph_hi = NPHASE;
    void* args[] = {&a};
    hipError_t e = hipLaunchCooperativeKernel((const void*)hybrid_fwd<true>, dim3(grid), dim3(NT), args, LDS_BYTES, stream);
    if (e != hipSuccess) fprintf(stderr, "cooperative launch failed: %s (grid %d)\n", hipGetErrorString(e), grid);
#else
    for (int ph = 0; ph < NPHASE; ++ph) { a.ph_lo = ph; a.ph_hi = ph + 1; hipLaunchKernelGGL(hybrid_fwd<false>, dim3(grid), dim3(NT), LDS_BYTES, stream, a); }
#endif
}
```

```cpp
#include <hip/hip_runtime.h>
#include <hip/hip_cooperative_groups.h>
#include <cstdio>
#include <cstdint>
namespace cg = cooperative_groups;

#ifndef MEGA
#define MEGA 1
#endif

namespace pg8 {
#define PG8_LAS __attribute__((address_space(3)))
typedef unsigned short bf16_t;
typedef short bf16x8 __attribute__((ext_vector_type(8)));
typedef float f32x4 __attribute__((ext_vector_type(4)));
typedef unsigned u32x4 __attribute__((ext_vector_type(4)));
typedef unsigned u32x2 __attribute__((ext_vector_type(2)));
constexpr int BM = 256, BK = 64, HALF = 128, HTB = HALF * BK * 2  , STAGE_BYTES = 8 * HTB, NXCD = 8, WGM = 8;

__host__ __device__ __forceinline__ int lds_byte(int r, int c) { const int st = (r >> 4) * 2 + (c >> 5), rr = r & 15, cc = c & 31, ob = rr * 64 + cc * 2; return st * 1024 + (ob ^ (((ob >> 9) & 1) << 5)); }
__host__ __device__ __forceinline__ void stage_rc(int b, int& R, int& C) { const int st = b / 1024, sb = b % 1024, swz = sb ^ (((sb >> 9) & 1) << 5); R = (st >> 1) * 16 + swz / 64; C = (st & 1) * 32 + (swz % 64) / 2; }
__host__ __device__ __forceinline__ int perm32(int rho) { const int n = rho >> 4, i = rho & 15; return 8 * (i >> 2) + 4 * n + (i & 3); }

struct Unit { int pm, pn; };
struct Gemm { const bf16_t* A; const bf16_t* Bt; int M, N, K; };

struct StaticOrder {
    int nM, nN, nwg, G, c;
    __host__ __device__ void init(int M, int N, int G_, int c_) { nM = M / BM; nN = N / BM; nwg = nM * nN; G = G_; c = c_; }
    __host__ __device__ bool next(int i, Unit& u) const {
        const long L = (long)i * G + c; if (L >= nwg) return false;
        int wgid = (int)L; { const int q = nwg / NXCD, r = nwg % NXCD, xcd = wgid % NXCD, off = wgid / NXCD; wgid = (xcd < r ? xcd * (q + 1) : r * (q + 1) + (xcd - r) * q) + off; }
        const int nig = WGM * nN, gid = wgid / nig, fm = gid * WGM, gsz = (nM - fm) < WGM ? (nM - fm) : WGM;
        u.pm = fm + ((wgid % nig) % gsz); u.pn = (wgid % nig) / gsz; return true;
    }
    __device__ __forceinline__ void a_ready(const Unit&) const {}
    __device__ __forceinline__ void done(const Unit&) const {}
};

typedef __bf16 bf16x2_cv __attribute__((ext_vector_type(2)));
typedef float f32x2_cv __attribute__((ext_vector_type(2)));
__device__ __forceinline__ unsigned cvt_pk_bf16(float lo, float hi) { const f32x2_cv v = {lo, hi}; return __builtin_bit_cast(unsigned, __builtin_convertvector(v, bf16x2_cv)); }
__device__ __forceinline__ float silu_f(float g) { return g * __builtin_amdgcn_rcpf(1.0f + __expf(-g)); }

struct EpiBf16 {
    static constexpr bool PERM = true, AFTER_DRAIN = false;
    bf16_t* O; int ldc;
    __device__ __forceinline__ void operator()(const f32x4 (&acc)[2][2][4][2], const Unit& u, int wr, int wc, int fr, int fq) const {
        const int row0 = u.pm * BM + wr * 64 + fr, col0 = u.pn * BM + wc * 32 + 8 * fq;
#pragma unroll
        for (int ai = 0; ai < 2; ++ai)
#pragma unroll
            for (int m = 0; m < 4; ++m) { bf16_t* rowp = O + (size_t)(row0 + ai * HALF + m * 16) * ldc + col0;
#pragma unroll
                for (int bj = 0; bj < 2; ++bj) { const f32x4 v0 = acc[ai][bj][m][0], v1 = acc[ai][bj][m][1];
                    u32x4 w; w.x = cvt_pk_bf16(v0[0], v0[1]); w.y = cvt_pk_bf16(v0[2], v0[3]); w.z = cvt_pk_bf16(v1[0], v1[1]); w.w = cvt_pk_bf16(v1[2], v1[3]);
                    *(u32x4*)(rowp + bj * HALF) = w; } }
    }
};
struct EpiSwiglu {
    static constexpr bool PERM = true, AFTER_DRAIN = false;
    bf16_t* O; int ldc;
    __device__ __forceinline__ void operator()(const f32x4 (&acc)[2][2][4][2], const Unit& u, int wr, int wc, int fr, int fq) const {
        const int row0 = u.pm * BM + wr * 64 + fr, col0 = u.pn * HALF + wc * 32 + 8 * fq;
#pragma unroll
        for (int ai = 0; ai < 2; ++ai)
#pragma unroll
            for (int m = 0; m < 4; ++m) { bf16_t* rowp = O + (size_t)(row0 + ai * HALF + m * 16) * ldc + col0;
                const f32x4 g0 = acc[ai][0][m][0], g1 = acc[ai][0][m][1], u0 = acc[ai][1][m][0], u1 = acc[ai][1][m][1];
                u32x4 w; w.x = cvt_pk_bf16(silu_f(g0[0]) * u0[0], silu_f(g0[1]) * u0[1]); w.y = cvt_pk_bf16(silu_f(g0[2]) * u0[2], silu_f(g0[3]) * u0[3]);
                w.z = cvt_pk_bf16(silu_f(g1[0]) * u1[0], silu_f(g1[1]) * u1[1]); w.w = cvt_pk_bf16(silu_f(g1[2]) * u1[2], silu_f(g1[3]) * u1[3]);
                *(u32x4*)rowp = w; }
    }
};

template <bool FINAL> struct EpiResNorm {
    static constexpr bool PERM = false, AFTER_DRAIN = true;
    const float* R; float* C; bf16_t* HB; const float* gain; float* slots; unsigned* cnt;
    __device__ __forceinline__ void fused(f32x4 (&acc)[2][2][4][2], const Unit& u, int wr, int wc, int fr, int fq, PG8_LAS unsigned char* lds, int wid, int lane) const {
        PG8_LAS float* Pt = (PG8_LAS float*)lds;
        PG8_LAS float* Rs = Pt + 1024;
        const int row0 = u.pm * BM + wr * 64 + fr, col0 = u.pn * BM + wc * 32 + 4 * fq, ldc = 2048;
#pragma unroll
        for (int ai = 0; ai < 2; ++ai)
#pragma unroll
            for (int m = 0; m < 4; ++m) { const size_t off = (size_t)(row0 + ai * HALF + m * 16) * ldc + col0; float ss = 0.f;
#pragma unroll
                for (int bj = 0; bj < 2; ++bj)
#pragma unroll
                    for (int n = 0; n < 2; ++n) { const f32x4 r = *(const f32x4*)(R + off + bj * HALF + n * 16); const f32x4 v = r + acc[ai][bj][m][n]; acc[ai][bj][m][n] = v;
                        ss += (v[0] * v[0] + v[1] * v[1]) + (v[2] * v[2] + v[3] * v[3]); }
                ss += __shfl_xor(ss, 16); ss += __shfl_xor(ss, 32);
                if (fq == 0) Pt[(ai * HALF + wr * 64 + m * 16 + fr) * 4 + wc] = ss; }
        __syncthreads();
        const int tid = wid * 64 + lane;
        if (wid < 4) {
            const f32x4 p4 = *(const PG8_LAS f32x4*)(Pt + tid * 4);
            __hip_atomic_store(slots + (size_t)(u.pm * BM + tid) * 8 + u.pn, (p4[0] + p4[1]) + (p4[2] + p4[3]), __ATOMIC_RELAXED, __HIP_MEMORY_SCOPE_AGENT);
            asm volatile("s_waitcnt vmcnt(0)" ::: "memory");
            if (lane == 0) (void)__hip_atomic_fetch_add(cnt + 16 * u.pm, 1u, __ATOMIC_RELAXED, __HIP_MEMORY_SCOPE_AGENT);
        }
        if (wid == 0) {
            unsigned spins = 0;
            while ((unsigned)__builtin_amdgcn_readfirstlane(__hip_atomic_load(cnt + 16 * u.pm, __ATOMIC_RELAXED, __HIP_MEMORY_SCOPE_AGENT)) < 32u) { __builtin_amdgcn_s_sleep(2); if (++spins > (1u << 18)) break; }
            __builtin_amdgcn_fence(__ATOMIC_ACQUIRE, "agent");
            asm volatile("s_waitcnt vmcnt(0)" ::: "memory");
        }
        __syncthreads();
        if (wid < 4) { float t = 0.f;
#pragma unroll
            for (int k = 0; k < 8; ++k) t += __hip_atomic_load(slots + (size_t)(u.pm * BM + tid) * 8 + k, __ATOMIC_RELAXED, __HIP_MEMORY_SCOPE_AGENT);
            Rs[tid] = 1.0f / sqrtf(t * (1.0f / 2048.0f) + 1e-6f); }
        __syncthreads();
        f32x4 gv[2][2];
#pragma unroll
        for (int bj = 0; bj < 2; ++bj)
#pragma unroll
            for (int n = 0; n < 2; ++n) gv[bj][n] = *(const f32x4*)(gain + col0 + bj * HALF + n * 16);
#pragma unroll
        for (int ai = 0; ai < 2; ++ai)
#pragma unroll
            for (int m = 0; m < 4; ++m) { const size_t off = (size_t)(row0 + ai * HALF + m * 16) * ldc + col0; const float rs = Rs[ai * HALF + wr * 64 + m * 16 + fr];
#pragma unroll
                for (int bj = 0; bj < 2; ++bj)
#pragma unroll
                    for (int n = 0; n < 2; ++n) { const f32x4 v = acc[ai][bj][m][n], y = v * rs * gv[bj][n];
                        if (FINAL) { *(f32x4*)(C + off + bj * HALF + n * 16) = y; }
                        else { *(f32x4*)(C + off + bj * HALF + n * 16) = v; u32x2 w; w.x = cvt_pk_bf16(y[0], y[1]); w.y = cvt_pk_bf16(y[2], y[3]); *(u32x2*)(HB + off + bj * HALF + n * 16) = w; } } }
    }
};

template <class Epi, class Sched, bool ALIGN_EPI = false, bool SP2 = false>
__device__ __forceinline__ void gemm_phase(PG8_LAS unsigned char* lds, const Gemm g, const Sched& S, const Epi& E) {
    int tid_ = threadIdx.x; asm volatile("" : "+v"(tid_));
    const int tid = tid_, wid = __builtin_amdgcn_readfirstlane(tid >> 6), lane = tid & 63, wr = wid >> 2, wc = wid & 3, fr = lane & 15, fq = lane >> 4;
    const int K = g.K, nt = K / BK;
    unsigned voffA[2], voffB[2];
#pragma unroll
    for (int i = 0; i < 2; ++i) { int R, C; stage_rc(tid * 16 + i * 8192, R, C); const int Rb = Epi::PERM ? ((R & ~31) + perm32(R & 31)) : R;
        voffA[i] = (unsigned)(R * K + C) * 2u; voffB[i] = (unsigned)(Rb * K + C) * 2u; }
    const size_t kstep = (size_t)(BK * 2);
    const size_t hstep = (size_t)HALF * K * 2;
    const size_t tstep = 2 * hstep;
    const unsigned ldsw = (unsigned)wid * 1024u;
    const int aoff = lds_byte(wr * 64 + fr, fq * 8), boff = lds_byte(wc * 32 + fr, fq * 8);
#define PG8_SA(b, h) (((b) * 2 + (h)) * HTB)
#define PG8_SB(b, h) ((4 + (b) * 2 + (h)) * HTB)
#define PG8_STAGE(bufoff, gbase, voff) do { _Pragma("unroll") for (int _i = 0; _i < 2; ++_i) \
        __builtin_amdgcn_global_load_lds((const unsigned*)((const char*)(gbase) + (voff)[_i]), (PG8_LAS unsigned*)(lds + (bufoff) + ldsw + _i * 8192), 16, 0, 0); } while (0)
#define PG8_LDA(dst, b, h) do { _Pragma("unroll") for (int m = 0; m < 4; ++m) _Pragma("unroll") for (int k = 0; k < 2; ++k) dst[m][k] = *(const PG8_LAS bf16x8*)(lds + PG8_SA(b, h) + aoff + m * 2048 + k * 1024); } while (0)
#define PG8_LDB(dst, b, h) do { _Pragma("unroll") for (int n = 0; n < 2; ++n) _Pragma("unroll") for (int k = 0; k < 2; ++k) dst[n][k] = *(const PG8_LAS bf16x8*)(lds + PG8_SB(b, h) + boff + n * 2048 + k * 1024); } while (0)
#define PG8_MMA(ai, bj, At, Bt) do { __builtin_amdgcn_s_setprio(1); _Pragma("unroll") for (int m = 0; m < 4; ++m) _Pragma("unroll") for (int n = 0; n < 2; ++n) _Pragma("unroll") for (int k = 0; k < 2; ++k) \
        acc[ai][bj][m][n] = __builtin_amdgcn_mfma_f32_16x16x32_bf16(Bt[n][k], At[m][k], acc[ai][bj][m][n], 0, 0, 0); __builtin_amdgcn_s_setprio(0); } while (0)
#define PG8_WAIT_V(n) asm volatile("s_waitcnt vmcnt(" #n ")" ::: "memory")
#define PG8_WAIT_L(n) asm volatile("s_waitcnt lgkmcnt(" #n ")" ::: "memory")
#define PG8_BAR __builtin_amdgcn_s_barrier()
#define PG8_SCHED __builtin_amdgcn_sched_barrier(0)
    Unit cur, nxt; int ui = 0;
    if (!S.next(0, cur)) return;
    f32x4 acc[2][2][4][2];
#pragma unroll
    for (int a = 0; a < 2; ++a)
#pragma unroll
        for (int b = 0; b < 2; ++b)
#pragma unroll
            for (int m = 0; m < 4; ++m)
#pragma unroll
                for (int n = 0; n < 2; ++n) acc[a][b][m][n] = (f32x4){0.f, 0.f, 0.f, 0.f};
    bf16x8 At[4][2], B0[2][2], B1[2][2];
    const char* cA = (const char*)g.A + (size_t)cur.pm * tstep; const char* cB = (const char*)g.Bt + (size_t)cur.pn * tstep;
    S.a_ready(cur);
    if constexpr (SP2) {
        PG8_STAGE(PG8_SB(0, 0), cB, voffB); PG8_STAGE(PG8_SB(0, 1), cB + hstep, voffB); PG8_STAGE(PG8_SA(0, 0), cA, voffA); PG8_STAGE(PG8_SA(0, 1), cA + hstep, voffA);
        if (wr == 1) PG8_BAR;
        PG8_WAIT_V(2); PG8_BAR;
        PG8_STAGE(PG8_SB(1, 0), cB + kstep, voffB); PG8_STAGE(PG8_SA(1, 0), cA + kstep, voffA); PG8_STAGE(PG8_SB(1, 1), cB + hstep + kstep, voffB);
        PG8_WAIT_V(6); PG8_BAR;
    } else {
        PG8_STAGE(PG8_SB(0, 0), cB, voffB); PG8_STAGE(PG8_SA(0, 0), cA, voffA); PG8_STAGE(PG8_SB(0, 1), cB + hstep, voffB); PG8_STAGE(PG8_SA(0, 1), cA + hstep, voffA);
        if (wr == 1) PG8_BAR;
        PG8_WAIT_V(4); PG8_BAR;
        PG8_STAGE(PG8_SB(1, 0), cB + kstep, voffB); PG8_STAGE(PG8_SA(1, 0), cA + kstep, voffA); PG8_STAGE(PG8_SB(1, 1), cB + hstep + kstep, voffB);
        PG8_WAIT_V(6); PG8_BAR;
    }
    for (;;) {
        const bool has_next = S.next(ui + 1, nxt);
        const char* nA = has_next ? (const char*)g.A + (size_t)nxt.pm * tstep : cA; const char* nB = has_next ? (const char*)g.Bt + (size_t)nxt.pn * tstep : cB;
        for (int t = 0; t < nt; t += 2) {
            const bool last = (t == nt - 2);
            const char* a1 = cA + (size_t)(t + 1) * kstep;
            const char* a2 = last ? nA : cA + (size_t)(t + 2) * kstep; const char* b2 = last ? nB : cB + (size_t)(t + 2) * kstep;
            const char* a3 = a2 + kstep; const char* b3 = b2 + kstep;
            if (last && has_next) S.a_ready(nxt);
            if constexpr (SP2) {
            PG8_LDB(B0, 0, 0); PG8_LDB(B1, 0, 1); PG8_SCHED; PG8_LDA(At, 0, 0); PG8_STAGE(PG8_SA(1, 1), a1 + hstep, voffA);
            PG8_WAIT_V(8); PG8_WAIT_L(0); PG8_BAR; PG8_MMA(0, 0, At, B0); PG8_MMA(0, 1, At, B1); PG8_BAR; PG8_SCHED;
            PG8_LDA(At, 0, 1); PG8_STAGE(PG8_SB(0, 0), b2, voffB); PG8_STAGE(PG8_SB(0, 1), b2 + hstep, voffB); PG8_STAGE(PG8_SA(0, 0), a2, voffA);
            PG8_WAIT_V(8); PG8_WAIT_L(0); PG8_BAR; PG8_MMA(1, 0, At, B0); PG8_MMA(1, 1, At, B1); PG8_BAR; PG8_SCHED;
            PG8_LDB(B0, 1, 0); PG8_LDB(B1, 1, 1); PG8_SCHED; PG8_LDA(At, 1, 0); PG8_STAGE(PG8_SA(0, 1), a2 + hstep, voffA);
            PG8_WAIT_V(8); PG8_WAIT_L(0); PG8_BAR; PG8_MMA(0, 0, At, B0); PG8_MMA(0, 1, At, B1); PG8_BAR; PG8_SCHED;
            PG8_LDA(At, 1, 1); PG8_STAGE(PG8_SB(1, 0), b3, voffB); PG8_STAGE(PG8_SB(1, 1), b3 + hstep, voffB); PG8_STAGE(PG8_SA(1, 0), a3, voffA);
            PG8_WAIT_V(8); PG8_WAIT_L(0); PG8_BAR; PG8_MMA(1, 0, At, B0); PG8_MMA(1, 1, At, B1); PG8_BAR; PG8_SCHED;
            } else {
            PG8_LDB(B0, 0, 0); PG8_SCHED; PG8_LDA(At, 0, 0); PG8_STAGE(PG8_SA(1, 1), a1 + hstep, voffA);
            PG8_WAIT_L(8); PG8_BAR; PG8_WAIT_L(0); PG8_MMA(0, 0, At, B0); PG8_BAR; PG8_SCHED;
            PG8_LDB(B1, 0, 1); PG8_STAGE(PG8_SB(0, 0), b2, voffB);
            PG8_BAR; PG8_WAIT_L(0); PG8_MMA(0, 1, At, B1); PG8_BAR;
            PG8_LDA(At, 0, 1); PG8_STAGE(PG8_SA(0, 0), a2, voffA);
            PG8_BAR; PG8_WAIT_L(0); PG8_MMA(1, 0, At, B0); PG8_BAR; PG8_SCHED;
            PG8_STAGE(PG8_SB(0, 1), b2 + hstep, voffB);
            PG8_WAIT_V(6); PG8_BAR; PG8_MMA(1, 1, At, B1); PG8_BAR;
            PG8_LDB(B0, 1, 0); PG8_SCHED; PG8_LDA(At, 1, 0); PG8_STAGE(PG8_SA(0, 1), a2 + hstep, voffA);
            PG8_WAIT_L(8); PG8_BAR; PG8_WAIT_L(0); PG8_MMA(0, 0, At, B0); PG8_BAR; PG8_SCHED;
            PG8_LDB(B1, 1, 1); PG8_STAGE(PG8_SB(1, 0), b3, voffB);
            PG8_BAR; PG8_WAIT_L(0); PG8_MMA(0, 1, At, B1); PG8_BAR;
            PG8_LDA(At, 1, 1); PG8_STAGE(PG8_SA(1, 0), a3, voffA);
            PG8_BAR; PG8_WAIT_L(0); PG8_MMA(1, 0, At, B0); PG8_BAR; PG8_SCHED;
            PG8_STAGE(PG8_SB(1, 1), b3 + hstep, voffB);
            PG8_WAIT_V(6); PG8_BAR; PG8_MMA(1, 1, At, B1); PG8_BAR;
            }
        }
        if constexpr (ALIGN_EPI) { if (wr == 0) PG8_BAR; }
        if constexpr (!Epi::AFTER_DRAIN) { E(acc, cur, wr, wc, fr, fq); S.done(cur); }
        if (!has_next) break;
#pragma unroll
        for (int a = 0; a < 2; ++a)
#pragma unroll
            for (int b = 0; b < 2; ++b)
#pragma unroll
                for (int m = 0; m < 4; ++m)
#pragma unroll
                    for (int n = 0; n < 2; ++n) acc[a][b][m][n] = (f32x4){0.f, 0.f, 0.f, 0.f};
        cur = nxt; cA = nA; cB = nB; ++ui;
        if constexpr (ALIGN_EPI) { if (wr == 1) PG8_BAR; }
    }
    PG8_WAIT_V(0);
    if constexpr (!ALIGN_EPI) { if (wr == 0) PG8_BAR; }
    PG8_BAR;
    if constexpr (Epi::AFTER_DRAIN) { E.fused(acc, cur, wr, wc, fr, fq, lds, wid, lane); S.done(cur); }
#undef PG8_SA
#undef PG8_SB
#undef PG8_STAGE
#undef PG8_LDA
#undef PG8_LDB
#undef PG8_MMA
#undef PG8_WAIT_V
#undef PG8_WAIT_L
#undef PG8_BAR
#undef PG8_SCHED
}
}

#define LAS __attribute__((address_space(3)))
typedef unsigned short bf16_t;
typedef float f32x4 __attribute__((ext_vector_type(4)));
typedef unsigned u32x4 __attribute__((ext_vector_type(4)));
typedef unsigned u32x2 __attribute__((ext_vector_type(2)));
constexpr int DM = 2048, SEQ = 2048, MTOK = 8192, DEPTH = 2;
constexpr int RH = 8, RW = 1024, LW = 1024, INW = 6144, DFF = 5632, NCH = 32;
constexpr float EPS = 1e-6f;
constexpr int NT = 512;
constexpr int LDS_BYTES = 136 * 1024;

constexpr size_t MiB = 1u << 20;
constexpr size_t WS_ROPE = 0;
constexpr size_t WS_WIN = 1 * MiB;
constexpr size_t WS_WOUT = 25 * MiB;
constexpr size_t WS_WGU = 33 * MiB;
constexpr size_t WS_WDN = 77 * MiB;
constexpr size_t WS_P = 99 * MiB;
constexpr size_t WS_U = 195 * MiB;
constexpr size_t WS_MIX = 259 * MiB;
constexpr size_t WS_H = 291 * MiB;
constexpr size_t WS_HL = 323 * MiB;
constexpr size_t WS_ACUM = 355 * MiB;
constexpr size_t WS_APROD = 387 * MiB;
constexpr size_t WS_HEND = 387 * MiB + 512 * 1024;
constexpr size_t WS_BAR = 388 * MiB;
constexpr size_t WS_CARRY = 389 * MiB;
constexpr size_t WS_WAT = 389 * MiB + 512 * 1024;
constexpr size_t WS_SB = 390 * MiB;
constexpr size_t WS_SLOTS = 422 * MiB;
constexpr size_t WS_CNT = 423 * MiB;
constexpr size_t WS_END = 424 * MiB;

__device__ __forceinline__ float bf2f(bf16_t v) { return __uint_as_float((unsigned)v << 16); }
typedef __bf16 bf16x2_hw __attribute__((ext_vector_type(2)));
typedef float f32x2_hw __attribute__((ext_vector_type(2)));
__device__ __forceinline__ unsigned pk2(float lo, float hi) { const f32x2_hw v = {lo, hi}; return __builtin_bit_cast(unsigned, __builtin_convertvector(v, bf16x2_hw)); }
__device__ __forceinline__ unsigned f2bf(float f) { return pk2(f, 0.f) & 0xffffu; }
__device__ __forceinline__ float wave_sum(float v) {
#pragma unroll
    for (int o = 1; o < 64; o <<= 1) v += __shfl_xor(v, o);
    return v;
}
__device__ __forceinline__ float sigmoid_f(float x) { return 1.0f / (1.0f + __expf(-x)); }
__device__ __forceinline__ float gelu_tanh_f(float x) {
    const float u = 0.7978845608028654f * (x + 0.044715f * x * x * x);
    const float t = 1.0f - 2.0f * __builtin_amdgcn_rcpf(1.0f + __expf(2.0f * u));
    return 0.5f * x * (1.0f + t);
}

struct Args { const float* in[18]; float* out; unsigned char* ws; int ph_lo, ph_hi; };

__device__ __forceinline__ void transpose_item(const float* W, int K, int N, bf16_t* WT, int k0, int n0, int dst_row0, LAS float* scr, int lane) {
    const int kk = lane >> 4, n4 = (lane & 15) * 4; f32x4 v[16];
#pragma unroll
    for (int i = 0; i < 16; ++i) v[i] = *(const f32x4*)(W + (size_t)(k0 + kk + 4 * i) * N + n0 + n4);
#pragma unroll
    for (int i = 0; i < 16; ++i) { LAS float* d = scr + (kk + 4 * i) * 65 + n4; d[0] = v[i][0]; d[1] = v[i][1]; d[2] = v[i][2]; d[3] = v[i][3]; }
    asm volatile("s_waitcnt lgkmcnt(0)" ::: "memory");
    const int c = lane & 7;
#pragma unroll
    for (int j = 0; j < 8; ++j) { const int n = (lane >> 3) + 8 * j; const LAS float* s = scr + (8 * c) * 65 + n;
        u32x4 o; o.x = pk2(s[0 * 65], s[1 * 65]); o.y = pk2(s[2 * 65], s[3 * 65]); o.z = pk2(s[4 * 65], s[5 * 65]); o.w = pk2(s[6 * 65], s[7 * 65]);
        *(u32x4*)(WT + (size_t)(dst_row0 + n) * K + k0 + 8 * c) = o; }
    asm volatile("s_waitcnt lgkmcnt(0)" ::: "memory");
}
__device__ __forceinline__ void convert_weights(const Args& a, int l, LAS unsigned char* lds, int gw, int NGW, int wave, int lane, int part) {
    LAS float* scr = (LAS float*)(lds + wave * 16640);
    const float* w_in = a.in[2] + (size_t)l * DM * INW; const float* w_out = a.in[12] + (size_t)l * DM * DM;
    const float* w_g = a.in[14] + (size_t)l * DM * DFF; const float* w_u = a.in[15] + (size_t)l * DM * DFF; const float* w_d = a.in[16] + (size_t)l * DFF * DM;
    bf16_t* WIN = (bf16_t*)(a.ws + WS_WIN); bf16_t* WOUT = (bf16_t*)(a.ws + WS_WOUT); bf16_t* WGU = (bf16_t*)(a.ws + WS_WGU); bf16_t* WDN = (bf16_t*)(a.ws + WS_WDN);
    constexpr int I_IN = (DM / 64) * (INW / 64), I_OUT = (DM / 64) * (DM / 64), I_G = (DM / 64) * (DFF / 64), I_D = (DFF / 64) * (DM / 64);
    constexpr int NITEMS = I_IN + I_OUT + 2 * I_G + I_D;
    const int it_lo = part == 2 ? I_IN + I_OUT : 0, it_hi = part == 1 ? I_IN + I_OUT : NITEMS;
    for (int it = it_lo + gw; it < it_hi; it += NGW) {
        int r = it; const float* W; bf16_t* WT; int K, N, dsel;
        if (r < I_IN) { W = w_in; WT = WIN; K = DM; N = INW; dsel = 0; }
        else if ((r -= I_IN) < I_OUT) { W = w_out; WT = WOUT; K = DM; N = DM; dsel = 0; }
        else if ((r -= I_OUT) < I_G) { W = w_g; WT = WGU; K = DM; N = DFF; dsel = 1; }
        else if ((r -= I_G) < I_G) { W = w_u; WT = WGU; K = DM; N = DFF; dsel = 2; }
        else { r -= I_G; W = w_d; WT = WDN; K = DFF; N = DM; dsel = 0; }
        const int nb = N / 64, kb = r / nb, n0 = (r % nb) * 64;
        const int dst = dsel == 0 ? n0 : (n0 >> 7) * 256 + (n0 & 127) + (dsel == 2 ? 128 : 0);
        transpose_item(W, K, N, WT, kb * 64, n0, dst, scr, lane);
    }
}
template <bool OUT_F32>
__device__ __forceinline__ void rmsnorm_rows(const float* X, const float* g, void* outp, int gw, int NGW, int lane) {
    f32x4 gv[8];
#pragma unroll
    for (int j = 0; j < 8; ++j) gv[j] = *(const f32x4*)(g + j * 256 + lane * 4);
    for (int m = gw; m < MTOK; m += NGW) {
        const float* xr = X + (size_t)m * DM; f32x4 v[8]; float s = 0.f;
#pragma unroll
        for (int j = 0; j < 8; ++j) { v[j] = *(const f32x4*)(xr + j * 256 + lane * 4); s += (v[j][0] * v[j][0] + v[j][1] * v[j][1]) + (v[j][2] * v[j][2] + v[j][3] * v[j][3]); }
        const float rs = 1.0f / sqrtf(wave_sum(s) * (1.0f / DM) + EPS);
        if (OUT_F32) { float* o = (float*)outp + (size_t)m * DM;
#pragma unroll
            for (int j = 0; j < 8; ++j) *(f32x4*)(o + j * 256 + lane * 4) = v[j] * rs * gv[j];
        } else { bf16_t* o = (bf16_t*)outp + (size_t)m * DM;
#pragma unroll
            for (int j = 0; j < 8; ++j) { const f32x4 y = v[j] * rs * gv[j]; u32x2 w; w.x = pk2(y[0], y[1]); w.y = pk2(y[2], y[3]); *(u32x2*)(o + j * 256 + lane * 4) = w; } }
    }
}
__device__ __forceinline__ void rope_table(float2* tab, int gtid, int NG) {
    for (int i = gtid; i < SEQ * 64; i += NG) { const int t = i >> 6, d = i & 63;
        const float inv = 1.0f / powf(10000.0f, (float)d * (1.0f / 64.0f)); const float ang = (float)t * inv;
        const double rev = (double)ang * 0.15915494309189535; const float fr = (float)(rev - floor(rev));
        tab[i] = make_float2(__builtin_amdgcn_cosf(fr), __builtin_amdgcn_sinf(fr)); }
}

typedef short bf16x8_t __attribute__((ext_vector_type(8)));
__device__ __forceinline__ unsigned off_b(unsigned row, unsigned ch) { return 256u * row + 16u * (ch ^ (((row & 3u) << 2) | ((row >> 2) & 3u))); }
typedef short s16x4 __attribute__((ext_vector_type(4)));
__device__ __forceinline__ unsigned tr_addr(unsigned R0, unsigned c, unsigned fr) { const unsigned q = fr >> 2, p = fr & 3; return off_b(R0 + q, 2 * c + (p >> 1)) + 8 * (p & 1); }
#define TR_READ2(d0, d1, a0, a1) asm volatile("ds_read_b64_tr_b16 %0, %2\n\tds_read_b64_tr_b16 %1, %3\n\ts_waitcnt lgkmcnt(0)" : "=&v"(d0), "=&v"(d1) : "v"(a0), "v"(a1) : "memory")
#define TR_READ4(d0, d1, d2, d3, a0, a1, a2, a3) asm volatile("ds_read_b64_tr_b16 %0, %4\n\tds_read_b64_tr_b16 %1, %5\n\tds_read_b64_tr_b16 %2, %6\n\tds_read_b64_tr_b16 %3, %7\n\ts_waitcnt lgkmcnt(0)" \
    : "=&v"(d0), "=&v"(d1), "=&v"(d2), "=&v"(d3) : "v"(a0), "v"(a1), "v"(a2), "v"(a3) : "memory")
template <int CTRL> __device__ __forceinline__ float dppf(float v) { return __int_as_float(__builtin_amdgcn_update_dpp(0, __float_as_int(v), CTRL, 0xf, 0xf, true)); }
__device__ __forceinline__ float row16_sum(float v) { v += dppf<0xB1>(v); v += dppf<0x4E>(v); v += dppf<0x141>(v); v += dppf<0x140>(v); return v; }
__device__ __forceinline__ bf16x8_t cat4(s16x4 a, s16x4 b) { return (bf16x8_t){a[0], a[1], a[2], a[3], b[0], b[1], b[2], b[3]}; }
__device__ __forceinline__ float ret_logg(int h) { return log1pf(-exp2f(-5.0f - (float)h)); }
__device__ __forceinline__ float bflo(unsigned w) { return __uint_as_float(w << 16); }
__device__ __forceinline__ float bfhi(unsigned w) { return __uint_as_float(w & 0xffff0000u); }
__device__ __forceinline__ void rope_apply(const u32x4 lo, const u32x4 hi, const f32x4 (&cs)[4], LAS unsigned char* img, int c, int ch, float scale) {
    float t1[8] = {bflo(lo.x), bfhi(lo.x), bflo(lo.y), bfhi(lo.y), bflo(lo.z), bfhi(lo.z), bflo(lo.w), bfhi(lo.w)};
    float t2[8] = {bflo(hi.x), bfhi(hi.x), bflo(hi.y), bfhi(hi.y), bflo(hi.z), bfhi(hi.z), bflo(hi.w), bfhi(hi.w)};
    float o1[8], o2[8];
#pragma unroll
    for (int k = 0; k < 4; ++k) {
        o1[2 * k] = (t1[2 * k] * cs[k][0] - t2[2 * k] * cs[k][1]) * scale; o2[2 * k] = (t1[2 * k] * cs[k][1] + t2[2 * k] * cs[k][0]) * scale;
        o1[2 * k + 1] = (t1[2 * k + 1] * cs[k][2] - t2[2 * k + 1] * cs[k][3]) * scale; o2[2 * k + 1] = (t1[2 * k + 1] * cs[k][3] + t2[2 * k + 1] * cs[k][2]) * scale; }
    u32x4 w1, w2; w1.x = pk2(o1[0], o1[1]); w1.y = pk2(o1[2], o1[3]); w1.z = pk2(o1[4], o1[5]); w1.w = pk2(o1[6], o1[7]);
    w2.x = pk2(o2[0], o2[1]); w2.y = pk2(o2[2], o2[3]); w2.z = pk2(o2[4], o2[5]); w2.w = pk2(o2[6], o2[7]);
    *(LAS u32x4*)(img + off_b(c, ch)) = w1; *(LAS u32x4*)(img + off_b(c, ch + 8)) = w2;
}
struct R1Regs { u32x4 klo, khi, v[2]; f32x4 cs[4]; };
__device__ __forceinline__ void ret1_load(R1Regs& r, const bf16_t* P, const float2* rope, int item, int tid) {
    const int b = item >> 8, n = (item >> 3) & 31, h = item & 7, row0 = b * SEQ + n * 64, c = tid >> 3, ch = tid & 7;
    const bf16_t* src = P + (size_t)(row0 + c) * INW + 1024 + h * 128; r.klo = *(const u32x4*)(src + 8 * ch); r.khi = *(const u32x4*)(src + 64 + 8 * ch);
    const float2* rp = rope + (n * 64 + c) * 64;
#pragma unroll
    for (int k = 0; k < 4; ++k) r.cs[k] = *(const f32x4*)(rp + 8 * ch + 2 * k);
#pragma unroll
    for (int k = 0; k < 2; ++k) { const int i = tid + NT * k; r.v[k] = *(const u32x4*)(P + (size_t)(row0 + (i >> 4)) * INW + 2048 + h * 128 + 8 * (i & 15)); }
}
__device__ __forceinline__ void ret_stage1_block(const Args& a, LAS unsigned char* lds, int bid, int G, int tid) {
    const bf16_t* P = (const bf16_t*)(a.ws + WS_P); const float2* rope = (const float2*)(a.ws + WS_ROPE); bf16_t* U = (bf16_t*)(a.ws + WS_U);
    LAS unsigned char* Ki = lds; LAS unsigned char* Vi = lds + 16384;
    const int lane = tid & 63, wave = tid >> 6, fr = lane & 15, fq = lane >> 4;
    const unsigned kb = (unsigned)(size_t)Ki, vb = (unsigned)(size_t)Vi;
    R1Regs rg;
    if (bid < 1024) ret1_load(rg, P, rope, bid, tid);
    for (int item = bid; item < 1024; item += G) {
        const int b = item >> 8, n = (item >> 3) & 31, h = item & 7; const float lg = ret_logg(h);
        { const int c = tid >> 3, ch = tid & 7; rope_apply(rg.klo, rg.khi, rg.cs, Ki, c, ch, 0.08838834764831845f * __expf(lg * (float)(63 - c)));
#pragma unroll
          for (int k = 0; k < 2; ++k) { const int i = tid + NT * k; *(LAS u32x4*)(Vi + off_b(i >> 4, i & 15)) = rg.v[k]; } }
        __syncthreads();
        if (item + G < 1024) ret1_load(rg, P, rope, item + G, tid);
        bf16x8_t af[2];
        { s16x4 x0, x1, x2, x3; TR_READ4(x0, x1, x2, x3, kb + tr_addr(8 * fq, wave, fr), kb + tr_addr(8 * fq + 4, wave, fr), kb + tr_addr(32 + 8 * fq, wave, fr), kb + tr_addr(32 + 8 * fq + 4, wave, fr)); af[0] = cat4(x0, x1); af[1] = cat4(x2, x3); }
        bf16_t* up = U + (size_t)((b * 8 + h) * 32 + n) * 16384 + (size_t)(16 * wave + fr) * 128 + 4 * fq;
#pragma unroll
        for (int eb = 0; eb < 8; ++eb) { f32x4 acc = (f32x4){0.f, 0.f, 0.f, 0.f};
            { s16x4 x0, x1, x2, x3; TR_READ4(x0, x1, x2, x3, vb + tr_addr(8 * fq, eb, fr), vb + tr_addr(8 * fq + 4, eb, fr), vb + tr_addr(32 + 8 * fq, eb, fr), vb + tr_addr(32 + 8 * fq + 4, eb, fr));
                acc = __builtin_amdgcn_mfma_f32_16x16x32_bf16(cat4(x0, x1), af[0], acc, 0, 0, 0); acc = __builtin_amdgcn_mfma_f32_16x16x32_bf16(cat4(x2, x3), af[1], acc, 0, 0, 0); }
            u32x2 w; w.x = pk2(acc[0], acc[1]); w.y = pk2(acc[2], acc[3]); *(u32x2*)(up + 16 * eb) = w; }
        __syncthreads();
    }
}
__device__ __forceinline__ void ret_scan(const Args& a, int gtid, int NG) {
    const u32x2* U4 = (const u32x2*)(a.ws + WS_U); u32x2* S2 = (u32x2*)(a.ws + WS_SB);
    for (int i = gtid; i < 32 * 4096; i += NG) { const int bh = i >> 12, q = i & 4095, h = bh & 7; const float dec = __expf(64.0f * ret_logg(h));
        const u32x2* ub = U4 + (size_t)bh * 32 * 4096 + q; u32x2* sb = S2 + (size_t)bh * 32 * 4096 + q; f32x4 s = (f32x4){0.f, 0.f, 0.f, 0.f};
#pragma unroll
        for (int nb = 0; nb < 32; nb += 16) { u32x2 uv[16];
#pragma unroll
            for (int n = 0; n < 16; ++n) uv[n] = ub[(size_t)(nb + n) * 4096];
#pragma unroll
            for (int n = 0; n < 16; ++n) { const f32x4 u = (f32x4){bflo(uv[n].x), bfhi(uv[n].x), bflo(uv[n].y), bfhi(uv[n].y)}; u32x2 w; w.x = pk2(s[0], s[1]); w.y = pk2(s[2], s[3]); sb[(size_t)(nb + n) * 4096] = w; s = s * dec + u; } } }
}
struct R3Regs { u32x4 qlo, qhi, klo, khi, v[2], sv[4]; f32x4 cs[4]; };
__device__ __forceinline__ void ret3_load(R3Regs& r, const bf16_t* P, const float2* rope, const bf16_t* SB, int item, int tid) {
    const int b = item >> 8, n = (item >> 3) & 31, h = item & 7, row0 = b * SEQ + n * 64, c = tid >> 3, ch = tid & 7;
    const bf16_t* pr = P + (size_t)(row0 + c) * INW + h * 128;
    r.qlo = *(const u32x4*)(pr + 8 * ch); r.qhi = *(const u32x4*)(pr + 64 + 8 * ch); r.klo = *(const u32x4*)(pr + 1024 + 8 * ch); r.khi = *(const u32x4*)(pr + 1024 + 64 + 8 * ch);
    const float2* rp = rope + (n * 64 + c) * 64;
#pragma unroll
    for (int k = 0; k < 4; ++k) r.cs[k] = *(const f32x4*)(rp + 8 * ch + 2 * k);
#pragma unroll
    for (int k = 0; k < 2; ++k) { const int i = tid + NT * k; const bf16_t* vr = P + (size_t)(row0 + (i >> 4)) * INW + h * 128 + 8 * (i & 15); r.v[k] = *(const u32x4*)(vr + 2048); }
    const bf16_t* sp = SB + (size_t)((b * 8 + h) * 32 + n) * 16384;
#pragma unroll
    for (int k = 0; k < 4; ++k) { const int i = tid + NT * k; r.sv[k] = *(const u32x4*)(sp + (size_t)(i >> 4) * 128 + 8 * (i & 15)); }
}
__device__ __forceinline__ void ret_stage3_block(const Args& a, int l, LAS unsigned char* lds, int bid, int G, int tid) {
    const bf16_t* P = (const bf16_t*)(a.ws + WS_P); const float2* rope = (const float2*)(a.ws + WS_ROPE); const bf16_t* SB = (const bf16_t*)(a.ws + WS_SB);
    bf16_t* MIX = (bf16_t*)(a.ws + WS_MIX); const float* gn_g = a.in[3] + l * RW;
    LAS unsigned char* Qi = lds; LAS unsigned char* Ki = lds + 16384; LAS unsigned char* Vi = lds + 32768; LAS unsigned char* Si = lds + 49152; LAS float* part = (LAS float*)(lds + 81920);
    const int lane = tid & 63, wave = tid >> 6, fr = lane & 15, fq = lane >> 4;
    R3Regs rg;
    if (bid < 1024) ret3_load(rg, P, rope, SB, bid, tid);
  for (int item = bid; item < 1024; item += G) {
    const int b = item >> 8, n = (item >> 3) & 31, h = item & 7, row0 = b * SEQ + n * 64; const float lg = ret_logg(h);
    { const int c = tid >> 3, ch = tid & 7; rope_apply(rg.qlo, rg.qhi, rg.cs, Qi, c, ch, 1.0f); rope_apply(rg.klo, rg.khi, rg.cs, Ki, c, ch, 0.08838834764831845f);
#pragma unroll
      for (int k = 0; k < 2; ++k) { const int i = tid + NT * k; *(LAS u32x4*)(Vi + off_b(i >> 4, i & 15)) = rg.v[k]; }
#pragma unroll
      for (int k = 0; k < 4; ++k) { const int i = tid + NT * k; *(LAS u32x4*)(Si + off_b(i >> 4, i & 15)) = rg.sv[k]; } }
    __syncthreads();
    u32x4 gpre[2];
#pragma unroll
    for (int k = 0; k < 2; ++k) { const int i = tid + NT * k; gpre[k] = *(const u32x4*)(P + (size_t)(row0 + (i >> 4)) * INW + 3072 + h * 128 + 8 * (i & 15)); }
    if (item + G < 1024) ret3_load(rg, P, rope, SB, item + G, tid);
    const int ab = wave & 3, eh = wave >> 2;
    const unsigned vb = (unsigned)(size_t)Vi, sbs = (unsigned)(size_t)Si;
    bf16x8_t qf[4];
#pragma unroll
    for (int ks = 0; ks < 4; ++ks) qf[ks] = *(const LAS bf16x8_t*)(Qi + off_b(16 * ab + fr, 4 * ks + fq));
    unsigned sp[4][2];
#pragma unroll
    for (int cb = 0; cb < 4; ++cb) { f32x4 acc = (f32x4){0.f, 0.f, 0.f, 0.f};
#pragma unroll
        for (int ks = 0; ks < 4; ++ks) { const bf16x8_t kf = *(const LAS bf16x8_t*)(Ki + off_b(16 * cb + fr, 4 * ks + fq)); acc = __builtin_amdgcn_mfma_f32_16x16x32_bf16(kf, qf[ks], acc, 0, 0, 0); }
        float d[4];
#pragma unroll
        for (int r = 0; r < 4; ++r) d[r] = acc[r] * __expf(lg * fabsf((float)(16 * ab + fr - (16 * cb + 4 * fq + r))));
        sp[cb][0] = pk2(d[0], d[1]); sp[cb][1] = pk2(d[2], d[3]); }
    f32x4 oi[4], oc[4];
#pragma unroll
    for (int e = 0; e < 4; ++e) { const int eb = 4 * eh + e; oi[e] = (f32x4){0.f, 0.f, 0.f, 0.f}; oc[e] = (f32x4){0.f, 0.f, 0.f, 0.f};
        {
            s16x4 x0, x1, x2, x3; TR_READ4(x0, x1, x2, x3, vb + tr_addr(4 * fq, eb, fr), vb + tr_addr(16 + 4 * fq, eb, fr), vb + tr_addr(32 + 4 * fq, eb, fr), vb + tr_addr(48 + 4 * fq, eb, fr));
            u32x4 aw; aw.x = sp[0][0]; aw.y = sp[0][1]; aw.z = sp[1][0]; aw.w = sp[1][1];
            oi[e] = __builtin_amdgcn_mfma_f32_16x16x32_bf16(__builtin_bit_cast(bf16x8_t, aw), cat4(x0, x1), oi[e], 0, 0, 0);
            aw.x = sp[2][0]; aw.y = sp[2][1]; aw.z = sp[3][0]; aw.w = sp[3][1];
            oi[e] = __builtin_amdgcn_mfma_f32_16x16x32_bf16(__builtin_bit_cast(bf16x8_t, aw), cat4(x2, x3), oi[e], 0, 0, 0); }
#pragma unroll
        for (int kp = 0; kp < 2; ++kp) { s16x4 x0, x1, x2, x3;
            TR_READ4(x0, x1, x2, x3, sbs + tr_addr(64 * kp + 8 * fq, eb, fr), sbs + tr_addr(64 * kp + 8 * fq + 4, eb, fr), sbs + tr_addr(64 * kp + 32 + 8 * fq, eb, fr), sbs + tr_addr(64 * kp + 32 + 8 * fq + 4, eb, fr));
            oc[e] = __builtin_amdgcn_mfma_f32_16x16x32_bf16(qf[2 * kp], cat4(x0, x1), oc[e], 0, 0, 0);
            oc[e] = __builtin_amdgcn_mfma_f32_16x16x32_bf16(qf[2 * kp + 1], cat4(x2, x3), oc[e], 0, 0, 0); } }
    float s1[4], s2[4];
#pragma unroll
    for (int r = 0; r < 4; ++r) { const float qd = __expf(lg * (float)(16 * ab + 4 * fq + r + 1)); s1[r] = 0.f; s2[r] = 0.f;
#pragma unroll
        for (int e = 0; e < 4; ++e) { const float v = oi[e][r] + qd * oc[e][r]; oi[e][r] = v; s1[r] += v; s2[r] += v * v; } }
#pragma unroll
    for (int r = 0; r < 4; ++r) { s1[r] = row16_sum(s1[r]); s2[r] = row16_sum(s2[r]);
        if (fr == 0) { part[(eh * 64 + 16 * ab + 4 * fq + r) * 2] = s1[r]; part[(eh * 64 + 16 * ab + 4 * fq + r) * 2 + 1] = s2[r]; } }
    __syncthreads();
    LAS bf16_t* Y = (LAS bf16_t*)lds;
    float gnv[4];
#pragma unroll
    for (int e = 0; e < 4; ++e) gnv[e] = gn_g[h * 128 + 16 * (4 * eh + e) + fr];
#pragma unroll
    for (int r = 0; r < 4; ++r) { const int aa = 16 * ab + 4 * fq + r;
        const float t1 = part[aa * 2] + part[(64 + aa) * 2], t2 = part[aa * 2 + 1] + part[(64 + aa) * 2 + 1];
        const float mu = t1 * (1.0f / 128.0f), var = fmaxf(t2 * (1.0f / 128.0f) - mu * mu, 0.f), rstd = __builtin_amdgcn_rsqf(var + EPS);
#pragma unroll
        for (int e = 0; e < 4; ++e) Y[aa * 136 + 16 * (4 * eh + e) + fr] = (bf16_t)f2bf((oi[e][r] - mu) * rstd * gnv[e]); }
    __syncthreads();
#pragma unroll
    for (int k = 0; k < 2; ++k) { const int c = tid + NT * k, row = c >> 4, ch = c & 15;
        const u32x4 yv = *(const LAS u32x4*)(Y + row * 136 + 8 * ch); const u32x4 gv = gpre[k]; u32x4 w;
        w.x = pk2(bflo(yv.x) * pg8::silu_f(bflo(gv.x)), bfhi(yv.x) * pg8::silu_f(bfhi(gv.x))); w.y = pk2(bflo(yv.y) * pg8::silu_f(bflo(gv.y)), bfhi(yv.y) * pg8::silu_f(bfhi(gv.y)));
        w.z = pk2(bflo(yv.z) * pg8::silu_f(bflo(gv.z)), bfhi(yv.z) * pg8::silu_f(bfhi(gv.z))); w.w = pk2(bflo(yv.w) * pg8::silu_f(bflo(gv.w)), bfhi(yv.w) * pg8::silu_f(bfhi(gv.w)));
        *(u32x4*)(MIX + (size_t)(row0 + row) * DM + h * 128 + 8 * ch) = w; }
    __syncthreads();
  }
}

__device__ __forceinline__ void lru_gate_weights(const Args& a, int gtid, int NG) {
    bf16_t* WAT = (bf16_t*)(a.ws + WS_WAT);
    for (int idx = gtid; idx < 2 * 16 * 2 * 4096; idx += NG) { const int i = idx & 63, j = (idx >> 6) & 63, gate = (idx >> 12) & 1, lg = idx >> 13;
        const float* w = (gate ? a.in[8] : a.in[6]) + (size_t)lg * 4096; WAT[idx] = (bf16_t)f2bf(w[i * 64 + j]); }
}
constexpr int XBS = 72;
__device__ __forceinline__ void lru_stage1_block(const Args& a, int l, LAS unsigned char* lds, int bid, int G, int tid) {
    const bf16_t* P = (const bf16_t*)(a.ws + WS_P);
    bf16_t* HL = (bf16_t*)(a.ws + WS_HL); bf16_t* ACUM = (bf16_t*)(a.ws + WS_ACUM); float* APROD = (float*)(a.ws + WS_APROD); float* HEND = (float*)(a.ws + WS_HEND);
    const float* conv_w = a.in[4] + l * 4 * LW; const float* conv_b = a.in[5] + l * LW; const float* ba = a.in[7] + l * LW; const float* bx = a.in[9] + l * LW; const float* lam = a.in[10] + l * LW;
    const bf16_t* WAT = (const bf16_t*)(a.ws + WS_WAT) + (size_t)l * 16 * 2 * 4096;
    LAS bf16_t* XB = (LAS bf16_t*)lds;
    LAS bf16_t* WT = XB + 64 * XBS;
    LAS float* XF = (LAS float*)(WT + 2 * 64 * XBS);
    LAS float* As = XF + 64 * 65; LAS float* Bs = As + 64 * 65; LAS float* segP = Bs + 64 * 65; LAS float* segH = segP + 512;
    const int lane = tid & 63, wave = tid >> 6, fr = lane & 15, fq = lane >> 4;
    const int per = (2048 + G - 1) / G; const int it_end = (bid + 1) * per < 2048 ? (bid + 1) * per : 2048;
    int gl = -1, gc = -1; float spv[2] = {0.f, 0.f}, bav[2] = {0.f, 0.f}, bxv[2] = {0.f, 0.f};
    const int j4 = (tid & 15) * 4;
    u32x2 xr[2][4];
#define LRU_LOADX(IT) do { const int bn_ = (IT) & 127, b_ = bn_ >> 5, n_ = bn_ & 31, c0_ = ((IT) >> 7) * 64; \
        _Pragma("unroll") for (int k = 0; k < 2; ++k) _Pragma("unroll") for (int q = 0; q < 4; ++q) { const int tt = n_ * 64 + (tid >> 4) + 32 * k + q - 3; \
            xr[k][q] = tt >= 0 ? *(const u32x2*)(P + (size_t)(b_ * SEQ + tt) * INW + 4096 + c0_ + j4) : (u32x2){0u, 0u}; } } while (0)
    if (bid * per < it_end) LRU_LOADX(bid * per);
    for (int it = bid * per; it < it_end; ++it) {
        const int g = it >> 7, bn = it & 127, b = bn >> 5, n = bn & 31, row0 = b * SEQ + n * 64, ch0 = g * 64;
        if (g != gl) { gl = g;
#pragma unroll
            for (int k = 0; k < 2; ++k) { const int c = tid + NT * k, gate = c >> 9, jr = (c >> 3) & 63, ic = (c & 7) * 8;
                *(LAS u32x4*)(WT + (gate * 64 + jr) * XBS + ic) = *(const u32x4*)(WAT + ((size_t)(g * 2 + gate) * 64 + jr) * 64 + ic); } }
        {
            f32x4 cw[4];
#pragma unroll
            for (int q = 0; q < 4; ++q) cw[q] = *(const f32x4*)(conv_w + q * LW + ch0 + j4);
            const f32x4 cb = *(const f32x4*)(conv_b + ch0 + j4);
#pragma unroll
            for (int k = 0; k < 2; ++k) { const int t = (tid >> 4) + 32 * k; f32x4 v = cb;
#pragma unroll
                for (int q = 0; q < 4; ++q) { const u32x2 r = xr[k][q];
                    v[0] += cw[q][0] * __uint_as_float(r.x << 16); v[1] += cw[q][1] * __uint_as_float(r.x & 0xffff0000u); v[2] += cw[q][2] * __uint_as_float(r.y << 16); v[3] += cw[q][3] * __uint_as_float(r.y & 0xffff0000u); }
                XF[t * 65 + j4] = v[0]; XF[t * 65 + j4 + 1] = v[1]; XF[t * 65 + j4 + 2] = v[2]; XF[t * 65 + j4 + 3] = v[3];
                u32x2 w; w.x = pk2(v[0], v[1]); w.y = pk2(v[2], v[3]); *(LAS u32x2*)(XB + t * XBS + j4) = w; }
        }
        if (it + 1 < it_end) LRU_LOADX(it + 1);
        __syncthreads();
        {
            const int tb = wave & 3, jp = wave >> 2; f32x4 acc[2][2];
#pragma unroll
            for (int ga = 0; ga < 2; ++ga)
#pragma unroll
                for (int jj = 0; jj < 2; ++jj) acc[ga][jj] = (f32x4){0.f, 0.f, 0.f, 0.f};
#pragma unroll
            for (int ks = 0; ks < 2; ++ks) { const bf16x8_t af = *(const LAS bf16x8_t*)(XB + (16 * tb + fr) * XBS + ks * 32 + 8 * fq);
#pragma unroll
                for (int ga = 0; ga < 2; ++ga)
#pragma unroll
                    for (int jj = 0; jj < 2; ++jj) { const bf16x8_t bfr = *(const LAS bf16x8_t*)(WT + (ga * 64 + 16 * (2 * jp + jj) + fr) * XBS + ks * 32 + 8 * fq);
                        acc[ga][jj] = __builtin_amdgcn_mfma_f32_16x16x32_bf16(af, bfr, acc[ga][jj], 0, 0, 0); } }
#pragma unroll
            for (int jj = 0; jj < 2; ++jj) { const int j = 16 * (2 * jp + jj) + fr;
                if (g != gc) { spv[jj] = -8.0f * log1pf(__expf(-lam[ch0 + j])); bav[jj] = ba[ch0 + j]; bxv[jj] = bx[ch0 + j]; }
#pragma unroll
                for (int r = 0; r < 4; ++r) { const int t = 16 * tb + 4 * fq + r;
                    const float rg = __builtin_amdgcn_rcpf(1.0f + __expf(-(acc[0][jj][r] + bav[jj]))), ig = __builtin_amdgcn_rcpf(1.0f + __expf(-(acc[1][jj][r] + bxv[jj])));
                    const float av = __expf(rg * spv[jj]);
                    As[t * 65 + j] = av; Bs[t * 65 + j] = sqrtf(fmaxf(1.0f - av * av, 0.f)) * (ig * XF[t * 65 + j]); } }
            gc = g;
        }
        __syncthreads();
        {
            const int sg = wave, j = lane; float av[8], bv[8];
#pragma unroll
            for (int k = 0; k < 8; ++k) { av[k] = As[(8 * sg + k) * 65 + j]; bv[k] = Bs[(8 * sg + k) * 65 + j]; }
            float pp = 1.f, hh = 0.f;
#pragma unroll
            for (int k = 0; k < 8; ++k) { hh = av[k] * hh + bv[k]; pp *= av[k]; }
            segP[sg * 64 + j] = pp; segH[sg * 64 + j] = hh;
            __syncthreads();
            float hc = 0.f, pc = 1.f;
#pragma unroll
            for (int q = 0; q < 7; ++q) { const float p2 = segP[q * 64 + j], h2 = segH[q * 64 + j]; if (q < sg) { hc = p2 * hc + h2; pc *= p2; } }
#pragma unroll
            for (int k = 0; k < 8; ++k) { hc = av[k] * hc + bv[k]; pc *= av[k]; const size_t o = (size_t)(row0 + 8 * sg + k) * LW + ch0 + j; HL[o] = (bf16_t)f2bf(hc); ACUM[o] = (bf16_t)f2bf(pc); }
            if (sg == 7) { APROD[(b * 32 + n) * LW + ch0 + j] = pc; HEND[(b * 32 + n) * LW + ch0 + j] = hc; }
        }
    }
    __syncthreads();
#undef LRU_LOADX
}
__device__ __forceinline__ void lru_carry_scan(const Args& a, int gtid) {
    const float* APROD = (const float*)(a.ws + WS_APROD); const float* HEND = (const float*)(a.ws + WS_HEND); float* CARRY = (float*)(a.ws + WS_CARRY);
    if (gtid < 4 * LW) { const int b = gtid >> 10, ch = gtid & 1023; float c = 0.f;
        float av[32], hv[32];
#pragma unroll
        for (int n = 0; n < 32; ++n) { const int o = (b * 32 + n) * LW + ch; av[n] = APROD[o]; hv[n] = HEND[o]; }
#pragma unroll
        for (int n = 0; n < 32; ++n) { CARRY[(b * 32 + n) * LW + ch] = c; c = av[n] * c + hv[n]; } }
}
__device__ __forceinline__ void lru_stage3(const Args& a, int l, int gw, int NGW, int lane) {
    const bf16_t* P = (const bf16_t*)(a.ws + WS_P); bf16_t* MIX = (bf16_t*)(a.ws + WS_MIX);
    const bf16_t* HL = (const bf16_t*)(a.ws + WS_HL); const bf16_t* ACUM = (const bf16_t*)(a.ws + WS_ACUM); const float* CARRY = (const float*)(a.ws + WS_CARRY);
    const float* norm_g = a.in[11] + l * LW;
    for (int tb = gw; tb < MTOK; tb += 4 * NGW) {
        f32x4 y[4][4]; float ss[4];
#pragma unroll
        for (int u = 0; u < 4; ++u) { const int t = (tb + u * NGW < MTOK) ? tb + u * NGW : tb, b = t >> 11, n = (t >> 6) & 31; ss[u] = 0.f;
#pragma unroll
            for (int k = 0; k < 4; ++k) { const int ch = k * 256 + lane * 4;
                const u32x2 hr = *(const u32x2*)(HL + (size_t)t * LW + ch), ar = *(const u32x2*)(ACUM + (size_t)t * LW + ch); const f32x4 cr = *(const f32x4*)(CARRY + (b * 32 + n) * LW + ch);
                const f32x4 hl = (f32x4){bflo(hr.x), bfhi(hr.x), bflo(hr.y), bfhi(hr.y)}, ac = (f32x4){bflo(ar.x), bfhi(ar.x), bflo(ar.y), bfhi(ar.y)};
                const u32x2 yr = *(const u32x2*)(P + (size_t)t * INW + 5120 + ch);
                const f32x4 hv = hl + ac * cr;
                y[u][k][0] = hv[0] * gelu_tanh_f(bflo(yr.x)); y[u][k][1] = hv[1] * gelu_tanh_f(bfhi(yr.x)); y[u][k][2] = hv[2] * gelu_tanh_f(bflo(yr.y)); y[u][k][3] = hv[3] * gelu_tanh_f(bfhi(yr.y));
                ss[u] += (y[u][k][0] * y[u][k][0] + y[u][k][1] * y[u][k][1]) + (y[u][k][2] * y[u][k][2] + y[u][k][3] * y[u][k][3]); } }
#pragma unroll
        for (int u = 0; u < 4; ++u) { const int t = (tb + u * NGW < MTOK) ? tb + u * NGW : tb; const float rs = __builtin_amdgcn_rsqf(wave_sum(ss[u]) * (1.0f / LW) + EPS);
#pragma unroll
            for (int k = 0; k < 4; ++k) { const int ch = k * 256 + lane * 4; const f32x4 gv = *(const f32x4*)(norm_g + ch); const f32x4 z = y[u][k] * rs * gv;
                u32x2 w; w.x = pk2(z[0], z[1]); w.y = pk2(z[2], z[3]); *(u32x2*)(MIX + (size_t)t * DM + 1024 + ch) = w; } } }
}

#define XB_TMO      128
#define XB_XCNT(j)  (256  + 64 * (j))
#define XB_XSUB(j)  (1280 + 64 * (j))
#define XB_XGEN(j)  (2304 + 64 * (j))
#define XB_TOP      3328
#define XB_TOPGEN   3392
#define XCD_BAR_WORDS 3456
#define XB_SPIN_CAP (1u << 18)

__device__ __forceinline__ unsigned xb_ld(unsigned* p)              { return __hip_atomic_load(p, __ATOMIC_RELAXED, __HIP_MEMORY_SCOPE_AGENT); }
__device__ __forceinline__ unsigned xb_add(unsigned* p, unsigned v) { return __hip_atomic_fetch_add(p, v, __ATOMIC_RELAXED, __HIP_MEMORY_SCOPE_AGENT); }
__device__ __forceinline__ unsigned xb_xcc_id() { return (unsigned)__builtin_amdgcn_s_getreg((3 << 11) | 20) & 0xFu; }
#define XB_SPIN(cond, bar) do { unsigned _sp = 0; while (cond) { __builtin_amdgcn_s_sleep(1); \
    if ((++_sp & 255u) == 0u) { if (xb_ld(&(bar)[XB_TMO])) break; if (_sp > XB_SPIN_CAP) { atomicAdd(&(bar)[XB_TMO], 1u); break; } } } } while (0)

struct XcdBarrier {
    unsigned* bar; unsigned x;
    volatile LAS unsigned* st;
};

__device__ __forceinline__ XcdBarrier xcd_barrier_post(unsigned* bar, volatile LAS unsigned* st) {
    XcdBarrier b; b.bar = bar; b.x = xb_xcc_id(); b.st = st;
    if (threadIdx.x == 0) (void)xb_add(&bar[XB_XCNT(b.x)], 1u);
    return b;
}
__device__ __forceinline__ void xcd_barrier_complete(unsigned* bar, unsigned x, unsigned& nloc, unsigned& nx) {
    const unsigned G = gridDim.x * gridDim.y * gridDim.z;
    unsigned sum, cnt, mine, sp = 0u;
    for (;;) {
        sum = 0u; cnt = 0u; mine = 0u;
#pragma unroll
        for (unsigned j = 0; j < 16; ++j) { const unsigned c = xb_ld(&bar[XB_XCNT(j)]); sum += c; cnt += (c > 0u) ? 1u : 0u; mine = (j == x) ? c : mine; }
        if (sum == G) break;
        __builtin_amdgcn_s_sleep(1);
        if ((++sp & 255u) == 0u) { if (xb_ld(&bar[XB_TMO])) break; if (sp > XB_SPIN_CAP) { atomicAdd(&bar[XB_TMO], 1u); break; } }
    }
    nloc = mine > 0u ? mine : 1u; nx = cnt > 0u ? cnt : 1u;
}

__device__ __forceinline__ void xcd_barrier(const XcdBarrier& b) {
    asm volatile("s_waitcnt vmcnt(0)" ::: "memory");
    __syncthreads();
    if (threadIdx.x == 0) {
        unsigned* bar = b.bar;
        __builtin_amdgcn_s_waitcnt(0);
        unsigned nloc = b.st[0], nx = b.st[1];
        if (nloc == 0u) { xcd_barrier_complete(bar, b.x, nloc, nx); b.st[0] = nloc; b.st[1] = nx; }
        const unsigned old = xb_add(&bar[XB_XSUB(b.x)], 1u);
        const unsigned gen = old / nloc;
        if (old + 1u == (gen + 1u) * nloc) {
            __builtin_amdgcn_fence(__ATOMIC_RELEASE, "agent");
            asm volatile("s_waitcnt vmcnt(0)" ::: "memory");
            const unsigned og = xb_add(&bar[XB_TOP], 1u);
            const unsigned tg = og / nx;
            if (og + 1u == (tg + 1u) * nx) xb_add(&bar[XB_TOPGEN], 1u);
            else XB_SPIN(xb_ld(&bar[XB_TOPGEN]) == tg, bar);
            __builtin_amdgcn_fence(__ATOMIC_ACQUIRE, "agent");
            xb_add(&bar[XB_XGEN(b.x)], 1u);
            asm volatile("s_waitcnt vmcnt(0)" ::: "memory");
        } else {
            XB_SPIN(xb_ld(&bar[XB_XGEN(b.x)]) == gen, bar);
            __builtin_amdgcn_fence(__ATOMIC_ACQUIRE, "agent");
            asm volatile("s_waitcnt vmcnt(0)" ::: "memory");
        }
    }
    __syncthreads();
}


constexpr int NPHASE = 16;
template <bool COOP>
__global__ void __launch_bounds__(NT, 2) hybrid_fwd(Args a) {
    extern __shared__ __attribute__((aligned(16))) unsigned char lds_raw[];
    LAS unsigned char* lds = (LAS unsigned char*)lds_raw;
    const int bid = blockIdx.x;
    bf16_t* WIN = (bf16_t*)(a.ws + WS_WIN); bf16_t* WOUT = (bf16_t*)(a.ws + WS_WOUT); bf16_t* WGU = (bf16_t*)(a.ws + WS_WGU); bf16_t* WDN = (bf16_t*)(a.ws + WS_WDN);
    bf16_t* PB = (bf16_t*)(a.ws + WS_P); bf16_t* MIX = (bf16_t*)(a.ws + WS_MIX); bf16_t* HB = (bf16_t*)(a.ws + WS_H);
    const unsigned long long pc0 = (unsigned long long)__builtin_amdgcn_s_getpc() & ~0xFFFull;
    const float* x_in = a.in[0]; float* XR = a.out; float* SLOTS = (float*)(a.ws + WS_SLOTS); unsigned* CNT = (unsigned*)(a.ws + WS_CNT);
    XcdBarrier xb; xb.bar = (unsigned*)(a.ws + WS_BAR); xb.x = 0; xb.st = nullptr;
    {
        volatile LAS unsigned* st = (volatile LAS unsigned*)(lds + LDS_BYTES - 16);
        if (threadIdx.x < 4) st[threadIdx.x] = 0u;
        if (a.ph_lo == 0 && bid == 0) {
            for (int i = threadIdx.x; i < XCD_BAR_WORDS; i += NT) ((unsigned*)(a.ws + WS_BAR))[i] = 0u;
            for (int i = threadIdx.x; i < 4 * 512; i += NT) ((unsigned*)(a.ws + WS_CNT))[i] = 0u; }
        __syncthreads();
    }
    for (int ph = a.ph_lo; ph < a.ph_hi; ++ph) {
        const int l = (ph - 1) / 8, sp = (ph == 0) ? -1 : (ph - 1) % 8;
        int tid_ = threadIdx.x; asm volatile("" : "+v"(tid_));
        int G_ = gridDim.x; asm volatile("" : "+s"(G_)); const int G = G_, NGW = G * 8, NG = G * NT;
        const int tid = tid_, lane = tid & 63, wave = __builtin_amdgcn_readfirstlane(tid >> 6), gw = bid * 8 + wave, gtid = bid * NT + tid;
        if (wave < 4) __builtin_amdgcn_global_load_lds((const unsigned*)(pc0 + (unsigned long long)(((bid >> 3) & 31) * 4096 + wave * 1024 + lane * 16)), (LAS unsigned*)(lds + 134144), 16, 0, 0);
        if (ph == 0) {
            convert_weights(a, 0, lds, wave * G + bid, NGW, wave, lane, 0);
            rope_table((float2*)(a.ws + WS_ROPE), gtid, NG);
            lru_gate_weights(a, gtid, NG);
            rmsnorm_rows<false>(x_in, a.in[1], HB, gw, NGW, lane);
        } else if (sp == 0) {
            pg8::Gemm g{HB, WIN, MTOK, INW, DM}; pg8::StaticOrder S; S.init(MTOK, INW, G, bid); pg8::EpiBf16 E{PB, INW};
            pg8::gemm_phase<pg8::EpiBf16, pg8::StaticOrder, true, true>(lds, g, S, E);
        } else if (sp == 1) {
            ret_stage1_block(a, lds, bid, G, tid);
            lru_stage1_block(a, l, lds, bid, G, tid);
        } else if (sp == 2) {
            lru_carry_scan(a, gtid);
            ret_scan(a, gtid, NG);
        } else if (sp == 3) {
            ret_stage3_block(a, l, lds, bid, G, tid);
            lru_stage3(a, l, gw, NGW, lane);
        } else if (sp == 4) {
            pg8::Gemm g{MIX, WOUT, MTOK, DM, DM}; pg8::StaticOrder S; S.init(MTOK, DM, G, bid);
            pg8::EpiResNorm<false> E{l == 0 ? x_in : XR, XR, HB, a.in[13] + l * DM, SLOTS + (size_t)(2 * l) * MTOK * 8, CNT + (2 * l) * 512};
            pg8::gemm_phase<pg8::EpiResNorm<false>, pg8::StaticOrder, true, true>(lds, g, S, E);
        } else if (sp == 5) {
            pg8::Gemm g{HB, WGU, MTOK, 2 * DFF, DM}; pg8::StaticOrder S; S.init(MTOK, 2 * DFF, G, bid); pg8::EpiSwiglu E{PB, DFF};
            pg8::gemm_phase<pg8::EpiSwiglu, pg8::StaticOrder, true, true>(lds, g, S, E);
            if (l == 0) { const int nt_all = (MTOK / 256) * (2 * DFF / 256), rem = nt_all % G;
                if (rem != 0 && bid >= rem) { __syncthreads(); convert_weights(a, 1, lds, wave * (G - rem) + (bid - rem), (G - rem) * 8, wave, lane, 1); }
                else if (rem == 0) { __syncthreads(); convert_weights(a, 1, lds, gw, NGW, wave, lane, 1); } }
        } else if (sp == 6) {
            pg8::Gemm g{PB, WDN, MTOK, DM, DFF}; pg8::StaticOrder S; S.init(MTOK, DM, G, bid);
            if (l == 0) { pg8::EpiResNorm<false> E{XR, XR, HB, a.in[1] + DM, SLOTS + (size_t)MTOK * 8, CNT + 512}; pg8::gemm_phase<pg8::EpiResNorm<false>, pg8::StaticOrder, true, true>(lds, g, S, E); }
            else { pg8::EpiResNorm<true> E{XR, XR, HB, a.in[17], SLOTS + (size_t)3 * MTOK * 8, CNT + 3 * 512}; pg8::gemm_phase<pg8::EpiResNorm<true>, pg8::StaticOrder, true, true>(lds, g, S, E); }
        } else {
            convert_weights(a, 1, lds, wave * G + bid, NGW, wave, lane, 2);
        }
        if (COOP) { if (ph + 1 < a.ph_hi) { if (ph == 0) { cg::this_grid().sync(); xb = xcd_barrier_post((unsigned*)(a.ws + WS_BAR), (volatile LAS unsigned*)(lds + LDS_BYTES - 16)); } else xcd_barrier(xb); } }
        else __syncthreads();
    }
}

extern "C" void kernel_launch(void* const* d_in, const int* in_sizes, int n_in, void* d_out, int out_size, void* d_ws, size_t ws_size, hipStream_t stream) {
    static int grid = 0;
    if (grid == 0) {
        if (n_in != 18 || out_size != MTOK * DM || ws_size < WS_END) { fprintf(stderr, "kernel_launch: unexpected shapes (n_in %d out %d ws %zu)\n", n_in, out_size, ws_size); grid = -1; return; }
        int dev = 0, cus = 0, per_cu = 0;
        hipGetDevice(&dev); hipDeviceGetAttribute(&cus, hipDeviceAttributeMultiprocessorCount, dev);
        hipFuncSetAttribute((const void*)hybrid_fwd<true>, hipFuncAttributeMaxDynamicSharedMemorySize, LDS_BYTES);
        hipFuncSetAttribute((const void*)hybrid_fwd<false>, hipFuncAttributeMaxDynamicSharedMemorySize, LDS_BYTES);
        hipOccupancyMaxActiveBlocksPerMultiprocessor(&per_cu, (const void*)hybrid_fwd<true>, NT, LDS_BYTES);
        if (per_cu < 1) { fprintf(stderr, "kernel_launch: occupancy query says %d blocks per CU\n", per_cu); per_cu = 1; }
        (void)hipGetLastError();
        grid = cus * 1;
    }
    if (grid < 0) return;
    Args a{};
    for (int i = 0; i < 18; ++i) a.in[i] = (const float*)d_in[i];
    a.out = (float*)d_out; a.ws = (unsigned char*)d_ws;
#if MEGA
    a.ph_lo = 0; a.ph_hi = NPHASE;
    void* args[] = {&a};
    hipError_t e = hipLaunchCooperativeKernel((const void*)hybrid_fwd<true>, dim3(grid), dim3(NT), args, LDS_BYTES, stream);
    if (e != hipSuccess) fprintf(stderr, "cooperative launch failed: %s (grid %d)\n", hipGetErrorString(e), grid);
#else
    for (int ph = 0; ph < NPHASE; ++ph) { a.ph_lo = ph; a.ph_hi = ph + 1; hipLaunchKernelGGL(hybrid_fwd<false>, dim3(grid), dim3(NT), LDS_BYTES, stream, a); }
#endif
}
```
